# Optimizing an MI355X kernel written in HIP

```python
import jax, jax.numpy as jnp
from jax import lax
import numpy as np

D_MODEL = 1024
BATCH = 2
SEQ = 8192
DEPTH = 2

HEAD_DIM = 64
MLA_HEADS = 6
MLA_NOPE = 64
MLA_ROPE = 32
MLA_V = 64
MLA_Q_LORA = 256
MLA_KV_LORA = 128
NSA_HEADS = 6
NSA_KV_HEADS = 2
NSA_GROUP = NSA_HEADS // NSA_KV_HEADS
NSA_BRANCHES = 3
CMP_LEN = 32
CMP_STRIDE = 16
CMP_HIDDEN = 128
SEL_LEN = 64
SEL_TOPK = 16
WINDOW = 512
SB_HEADS = 4
D_MIX = MLA_HEADS * MLA_V + NSA_HEADS * HEAD_DIM + SB_HEADS * HEAD_DIM
D_FF = 2816
ROPE_THETA = 500000.0
PARTIAL_ROT = HEAD_DIM // 4
Q_BLOCK = 128
EPS = 1e-6
NEG_INF = -1e30
FORCE_SCORE = 1e4
NSA_KV_W = NSA_KV_HEADS * HEAD_DIM
IN_WIDTHS = (MLA_Q_LORA, MLA_KV_LORA, MLA_ROPE,
             NSA_HEADS * HEAD_DIM,
             NSA_KV_W, NSA_KV_W, NSA_KV_W, NSA_KV_W, NSA_KV_W, NSA_KV_W,
             NSA_HEADS * NSA_BRANCHES,
             SB_HEADS * HEAD_DIM, SB_HEADS * HEAD_DIM, SB_HEADS * HEAD_DIM)
D_IN = sum(IN_WIDTHS)

kernel_name = 'hybrid_mla_nsa_stickbreak_macaron'


def rmsnorm(x, g):
    xf = x.astype(jnp.float32)
    y = xf * lax.rsqrt(jnp.mean(xf * xf, axis=-1, keepdims=True) + EPS)
    return (y * g.astype(jnp.float32)).astype(x.dtype)


def rope(x, pos, rot_dim):
    half = rot_dim // 2
    inv_freq = ROPE_THETA ** (-jnp.arange(half, dtype=jnp.float32) / half)
    ang = pos.astype(jnp.float32)[:, None] * inv_freq[None, :]
    cos = jnp.cos(ang)[:, None, :]
    sin = jnp.sin(ang)[:, None, :]
    xr = x[..., :rot_dim].astype(jnp.float32)
    x1, x2 = xr[..., :half], xr[..., half:]
    rot = jnp.concatenate([x1 * cos - x2 * sin, x2 * cos + x1 * sin], axis=-1)
    return jnp.concatenate([rot.astype(x.dtype), x[..., rot_dim:]], axis=-1)


def masked_softmax(s, mask):
    return jax.nn.softmax(jnp.where(mask, s.astype(jnp.float32), NEG_INF), axis=-1)


def swiglu(h, w_gate, w_up, w_down):
    return (jax.nn.silu(h @ w_gate) * (h @ w_up)) @ w_down


def split_heads(t, n_heads):
    b, s, _ = t.shape
    return t.reshape(b, s, n_heads, -1)


def sweep_query_blocks(block_fn, n_blocks):
    out = lax.map(block_fn, jnp.arange(n_blocks, dtype=jnp.int32))
    nb, b, q, h, d = out.shape
    return out.transpose(1, 0, 2, 3, 4).reshape(b, nb * q, h, d)


def mla_attention(c_q, c_kv, k_rope, q_norm, w_uq, kv_norm, w_ukv, pos):
    b, s, _ = c_q.shape
    q = (rmsnorm(c_q, q_norm) @ w_uq).reshape(b, s, MLA_HEADS, MLA_NOPE + MLA_ROPE)
    q_nope = q[..., :MLA_NOPE]
    q_pe = rope(q[..., MLA_NOPE:], pos, MLA_ROPE)
    kv = (rmsnorm(c_kv, kv_norm) @ w_ukv).reshape(b, s, MLA_HEADS, MLA_NOPE + MLA_V)
    k_nope, v = kv[..., :MLA_NOPE], kv[..., MLA_NOPE:]
    k_pe = rope(k_rope[:, :, None, :], pos, MLA_ROPE)[:, :, 0]
    scale = (MLA_NOPE + MLA_ROPE) ** -0.5

    def block(i):
        q0 = i * Q_BLOCK
        qn = lax.dynamic_slice_in_dim(q_nope, q0, Q_BLOCK, axis=1)
        qp = lax.dynamic_slice_in_dim(q_pe, q0, Q_BLOCK, axis=1)
        sc = (jnp.einsum('bqhd,bkhd->bhqk', qn, k_nope)
              + jnp.einsum('bqhr,bkr->bhqk', qp, k_pe)).astype(jnp.float32) * scale
        qpos = q0 + jnp.arange(Q_BLOCK)
        p = masked_softmax(sc, pos[None, :] <= qpos[:, None]).astype(v.dtype)
        return jnp.einsum('bhqk,bkhd->bqhd', p, v)

    return sweep_query_blocks(block, s // Q_BLOCK)


def compress_blocks(x, pos_emb, w1, w2):
    b, s, g, d = x.shape
    chunks = x.reshape(b, s // CMP_STRIDE, CMP_STRIDE, g, d)
    blocks = jnp.concatenate([chunks[:, :-1], chunks[:, 1:]], axis=2)
    blocks = blocks + pos_emb[None, None, :, None, :]
    flat = blocks.transpose(0, 1, 3, 2, 4).reshape(b, s // CMP_STRIDE - 1, g, CMP_LEN * d)
    return jax.nn.gelu(flat @ w1) @ w2


def nsa_attention(q, k_cmp, v_cmp, k_sel, v_sel, k_win, v_win, gates,
                  cmp_pos_k, cmp_w1_k, cmp_w2_k, cmp_pos_v, cmp_w1_v, cmp_w2_v, pos):
    b, s, h, d = q.shape
    q = rope(q, pos, PARTIAL_ROT)
    k_cmp = rope(k_cmp, pos, PARTIAL_ROT)
    k_sel = rope(k_sel, pos, PARTIAL_ROT)
    k_win = rope(k_win, pos, PARTIAL_ROT)
    scale = d ** -0.5
    kc = compress_blocks(k_cmp, cmp_pos_k, cmp_w1_k, cmp_w2_k)
    vc = compress_blocks(v_cmp, cmp_pos_v, cmp_w1_v, cmp_w2_v)
    n_cmp = s // CMP_STRIDE - 1
    cmp_start = jnp.arange(n_cmp) * CMP_STRIDE
    cmp_end = cmp_start + CMP_LEN - 1
    n_slc = s // SEL_LEN
    n_top = min(SEL_TOPK, n_slc)
    slc_start = jnp.arange(n_slc) * SEL_LEN
    overlap = ((cmp_start[:, None] < slc_start[None, :] + SEL_LEN)
               & (cmp_start[:, None] + CMP_LEN > slc_start[None, :])).astype(jnp.float32)
    ksb = k_sel.reshape(b, n_slc, SEL_LEN, NSA_KV_HEADS, d).transpose(0, 3, 1, 2, 4)
    vsb = v_sel.reshape(b, n_slc, SEL_LEN, NSA_KV_HEADS, d).transpose(0, 3, 1, 2, 4)
    b_ix = jnp.arange(b)[:, None, None, None]
    g_ix = jnp.arange(NSA_KV_HEADS)[None, :, None, None]
    blk = jnp.arange(n_slc)
    kw = jnp.pad(k_win, ((0, 0), (WINDOW, 0), (0, 0), (0, 0)))
    vw = jnp.pad(v_win, ((0, 0), (WINDOW, 0), (0, 0), (0, 0)))

    def block(i):
        q0 = i * Q_BLOCK
        qpos = q0 + jnp.arange(Q_BLOCK)
        qb = lax.dynamic_slice_in_dim(q, q0, Q_BLOCK, axis=1).reshape(b, Q_BLOCK, NSA_KV_HEADS, NSA_GROUP, d)
        sc = jnp.einsum('bqgrd,bcgd->bgrqc', qb, kc).astype(jnp.float32) * scale
        cmask = cmp_end[None, :] <= qpos[:, None]
        p_cmp = masked_softmax(sc, cmask)
        p_cmp = jnp.where(cmask.any(axis=-1)[:, None], p_cmp, 0.0)
        o_cmp = jnp.einsum('bgrqc,bcgd->bqgrd', p_cmp.astype(vc.dtype), vc)
        score = jnp.einsum('bgrqc,cn->bgqn', p_cmp, overlap)
        cur = qpos // SEL_LEN
        forced = (blk[None, :] == 0) | (blk[None, :] == cur[:, None]) | (blk[None, :] == cur[:, None] - 1)
        future = blk[None, :] > cur[:, None]
        score = jnp.where(forced, FORCE_SCORE, jnp.where(future, -1.0, score))
        _, idx = lax.top_k(score, n_top)
        kg = ksb[b_ix, g_ix, idx]
        vg = vsb[b_ix, g_ix, idx]
        tok = idx[..., None] * SEL_LEN + jnp.arange(SEL_LEN)
        smask = (tok <= qpos[None, None, :, None, None])[:, :, None]
        ss = jnp.einsum('bqgrd,bgqnld->bgrqnl', qb, kg).astype(jnp.float32) * scale
        ss = jnp.where(smask, ss, NEG_INF).reshape(b, NSA_KV_HEADS, NSA_GROUP, Q_BLOCK, n_top * SEL_LEN)
        p_sel = jax.nn.softmax(ss, axis=-1).astype(vg.dtype).reshape(b, NSA_KV_HEADS, NSA_GROUP, Q_BLOCK, n_top, SEL_LEN)
        o_sel = jnp.einsum('bgrqnl,bgqnld->bqgrd', p_sel, vg)
        kwb = lax.dynamic_slice_in_dim(kw, q0, WINDOW + Q_BLOCK, axis=1)
        vwb = lax.dynamic_slice_in_dim(vw, q0, WINDOW + Q_BLOCK, axis=1)
        wpos = q0 - WINDOW + jnp.arange(WINDOW + Q_BLOCK)
        wmask = ((wpos[None, :] <= qpos[:, None]) & (wpos[None, :] > qpos[:, None] - WINDOW)
                 & (wpos[None, :] >= 0))
        sw = jnp.einsum('bqgrd,bkgd->bgrqk', qb, kwb).astype(jnp.float32) * scale
        p_win = masked_softmax(sw, wmask).astype(vwb.dtype)
        o_win = jnp.einsum('bgrqk,bkgd->bqgrd', p_win, vwb)
        g = lax.dynamic_slice_in_dim(gates, q0, Q_BLOCK, axis=1).reshape(b, Q_BLOCK, NSA_KV_HEADS, NSA_GROUP, NSA_BRANCHES)
        o = g[..., 0:1] * o_cmp + g[..., 1:2] * o_sel + g[..., 2:3] * o_win
        return o.reshape(b, Q_BLOCK, h, d)

    return sweep_query_blocks(block, s // Q_BLOCK)


def stick_breaking_attention(q, k, v):
    b, s, h, d = q.shape
    scale = d ** -0.5
    kpos = jnp.arange(s)

    def block(i):
        q0 = i * Q_BLOCK
        qpos = q0 + jnp.arange(Q_BLOCK)
        qb = lax.dynamic_slice_in_dim(q, q0, Q_BLOCK, axis=1)
        z = jnp.einsum('bqhd,bkhd->bhqk', qb, k).astype(jnp.float32) * scale
        strict = kpos[None, :] < qpos[:, None]
        log_beta = jax.nn.log_sigmoid(z)
        log_rem = jnp.where(strict, jax.nn.log_sigmoid(-z), 0.0)
        suffix = lax.cumsum(log_rem, axis=3, reverse=True) - log_rem
        a = jnp.where(strict, jnp.exp(log_beta + suffix), 0.0).astype(v.dtype)
        return jnp.einsum('bhqk,bkhd->bqhd', a, v)

    return sweep_query_blocks(block, s // Q_BLOCK)


def setup_inputs(seed: int = 0) -> dict:
    key = jax.random.key(seed)
    ks = iter(jax.random.split(key, 32))
    f32 = jnp.float32
    L = DEPTH

    def nrm(shape, fan_in):
        return jax.random.normal(next(ks), shape, f32) * (fan_in ** -0.5)

    def gain(shape):
        return 1.0 + 0.02 * jax.random.normal(next(ks), shape, f32)

    return {
        'x': jax.random.normal(next(ks), (BATCH, SEQ, D_MODEL), f32),
        'ffn1_norm': gain((L, D_MODEL)),
        'ffn1_w_gate': nrm((L, D_MODEL, D_FF), D_MODEL),
        'ffn1_w_up': nrm((L, D_MODEL, D_FF), D_MODEL),
        'ffn1_w_down': nrm((L, D_FF, D_MODEL), D_FF),
        'mix_norm': gain((L, D_MODEL)),
        'w_in': nrm((L, D_MODEL, D_IN), D_MODEL),
        'mla_q_norm': gain((L, MLA_Q_LORA)),
        'mla_w_uq': nrm((L, MLA_Q_LORA, MLA_HEADS * (MLA_NOPE + MLA_ROPE)), MLA_Q_LORA),
        'mla_kv_norm': gain((L, MLA_KV_LORA)),
        'mla_w_ukv': nrm((L, MLA_KV_LORA, MLA_HEADS * (MLA_NOPE + MLA_V)), MLA_KV_LORA),
        'nsa_gate_bias': 0.1 * jax.random.normal(next(ks), (L, NSA_HEADS * NSA_BRANCHES), f32),
        'nsa_cmp_pos_k': 0.1 * jax.random.normal(next(ks), (L, CMP_LEN, HEAD_DIM), f32),
        'nsa_cmp_w1_k': nrm((L, CMP_LEN * HEAD_DIM, CMP_HIDDEN), CMP_LEN * HEAD_DIM),
        'nsa_cmp_w2_k': nrm((L, CMP_HIDDEN, HEAD_DIM), CMP_HIDDEN),
        'nsa_cmp_pos_v': 0.1 * jax.random.normal(next(ks), (L, CMP_LEN, HEAD_DIM), f32),
        'nsa_cmp_w1_v': nrm((L, CMP_LEN * HEAD_DIM, CMP_HIDDEN), CMP_LEN * HEAD_DIM),
        'nsa_cmp_w2_v': nrm((L, CMP_HIDDEN, HEAD_DIM), CMP_HIDDEN),
        'w_out': nrm((L, D_MIX, D_MODEL), D_MIX),
        'ffn2_norm': gain((L, D_MODEL)),
        'ffn2_w_gate': nrm((L, D_MODEL, D_FF), D_MODEL),
        'ffn2_w_up': nrm((L, D_MODEL, D_FF), D_MODEL),
        'ffn2_w_down': nrm((L, D_FF, D_MODEL), D_FF),
        'final_norm': gain((D_MODEL,)),
    }


def reference(x, ffn1_norm, ffn1_w_gate, ffn1_w_up, ffn1_w_down, mix_norm, w_in,
              mla_q_norm, mla_w_uq, mla_kv_norm, mla_w_ukv,
              nsa_gate_bias, nsa_cmp_pos_k, nsa_cmp_w1_k, nsa_cmp_w2_k,
              nsa_cmp_pos_v, nsa_cmp_w1_v, nsa_cmp_w2_v, w_out,
              ffn2_norm, ffn2_w_gate, ffn2_w_up, ffn2_w_down, final_norm):
    b, s, _ = x.shape
    pos = jnp.arange(s, dtype=jnp.int32)
    split_at = [int(c) for c in np.cumsum(IN_WIDTHS)[:-1]]
    for l in range(DEPTH):
        x = x + 0.5 * swiglu(rmsnorm(x, ffn1_norm[l]), ffn1_w_gate[l], ffn1_w_up[l], ffn1_w_down[l])
        h = rmsnorm(x, mix_norm[l])
        (c_q, c_kv, k_rope, n_q, n_kc, n_vc, n_ks, n_vs, n_kw, n_vw, n_gate,
         sb_q, sb_k, sb_v) = jnp.split(h @ w_in[l], split_at, axis=-1)
        o_mla = mla_attention(c_q, c_kv, k_rope, mla_q_norm[l], mla_w_uq[l],
                              mla_kv_norm[l], mla_w_ukv[l], pos)
        gates = jax.nn.sigmoid(n_gate + nsa_gate_bias[l]).reshape(b, s, NSA_HEADS, NSA_BRANCHES)
        o_nsa = nsa_attention(split_heads(n_q, NSA_HEADS),
                              split_heads(n_kc, NSA_KV_HEADS), split_heads(n_vc, NSA_KV_HEADS),
                              split_heads(n_ks, NSA_KV_HEADS), split_heads(n_vs, NSA_KV_HEADS),
                              split_heads(n_kw, NSA_KV_HEADS), split_heads(n_vw, NSA_KV_HEADS),
                              gates, nsa_cmp_pos_k[l], nsa_cmp_w1_k[l], nsa_cmp_w2_k[l],
                              nsa_cmp_pos_v[l], nsa_cmp_w1_v[l], nsa_cmp_w2_v[l], pos)
        o_sb = stick_breaking_attention(split_heads(sb_q, SB_HEADS), split_heads(sb_k, SB_HEADS),
                                        split_heads(sb_v, SB_HEADS))
        o = jnp.concatenate([o_mla.reshape(b, s, -1), o_nsa.reshape(b, s, -1),
                             o_sb.reshape(b, s, -1)], axis=-1)
        x = x + o @ w_out[l]
        x = x + 0.5 * swiglu(rmsnorm(x, ffn2_norm[l]), ffn2_w_gate[l], ffn2_w_up[l], ffn2_w_down[l])
    return rmsnorm(x, final_norm)
```

```cpp
#include <hip/hip_runtime.h>
#include <hip/hip_cooperative_groups.h>
#include <cstdio>
#include <cstdint>
namespace cg = cooperative_groups;
#ifndef GS_REP
#define GS_REP 1
#endif
#ifndef REP_A2
#define REP_A2 1
#endif
#ifndef REP_NORM
#define REP_NORM 1
#endif
#ifndef REP_G2
#define REP_G2 1
#endif
#ifndef REP_A1
#define REP_A1 1
#endif
#ifndef REP_A3
#define REP_A3 1
#endif
#ifndef REP_FFN
#define REP_FFN 1
#endif
#ifndef REP_CONV
#define REP_CONV 1
#endif

#define LAS __attribute__((address_space(3)))
typedef unsigned short bf16_t;
typedef short bf16x8 __attribute__((ext_vector_type(8)));
typedef short s16x4 __attribute__((ext_vector_type(4)));
typedef float f32x2 __attribute__((ext_vector_type(2)));
typedef float f32x4 __attribute__((ext_vector_type(4)));
typedef float f32x16 __attribute__((ext_vector_type(16)));
typedef unsigned u32x2 __attribute__((ext_vector_type(2)));
typedef unsigned u32x4 __attribute__((ext_vector_type(4)));
typedef __bf16 bf16x2_t __attribute__((ext_vector_type(2)));
#define DI __device__ __forceinline__

constexpr int SEQ = 8192, BATCH = 2, MTOK = BATCH * SEQ, DM = 1024, DFF = 2816, DIN = 2354, NPROJ = 2560;
constexpr int NCMP = 511;
constexpr float EPS = 1e-6f;
constexpr float LOG2E = 1.4426950408889634f;
constexpr int PC_CQ = 0, PC_CKV = 256, PC_KR = 384, PC_NQ = 416, PC_KC = 800, PC_VC = 928, PC_KS = 1056, PC_VS = 1184, PC_KW = 1312, PC_VW = 1440,
              PC_SBQ = 1568, PC_SBK = 1824, PC_SBV = 2080, PC_GATE = 2336;
constexpr size_t MiB = 1u << 20;
constexpr size_t WS_CTL = 0, WS_WGU = 1 * MiB, WS_WD = 12 * MiB, WS_WIN = 18 * MiB, WS_WOUT = 23 * MiB, WS_WC1 = 25 * MiB, WS_WUQ = 26 * MiB,
                 WS_WUKV = 26 * MiB + 512 * 1024, WS_WC2 = 26 * MiB + 768 * 1024, WS_HN = 28 * MiB, WS_R = 60 * MiB, WS_GATES = 140 * MiB,
                 WS_MASK = 142 * MiB, WS_LSE = 142 * MiB + 512 * 1024, WS_HID = 143 * MiB, WS_KCVC = 145 * MiB, WS_QMLA = 148 * MiB,
                 WS_KVB = 166 * MiB, WS_OCMP = 190 * MiB, WS_FLAT = 202 * MiB, WS_S1 = 202 * MiB, WS_S2 = 218 * MiB, WS_ROPE = 234 * MiB, WS_PART = 236 * MiB, WS_END = 252 * MiB;
constexpr size_t ROPE_MLA_COS = 0, ROPE_MLA_SIN = 8192 * 16, ROPE_NSA_COS = 2 * 8192 * 16, ROPE_NSA_SIN = 2 * 8192 * 16 + 8192 * 8;
constexpr int LDS_BYTES = 131072 + 1024;
constexpr int PTAB = 131072 + 64;

DI unsigned cvtpk(float lo, float hi) { f32x2 v = {lo, hi}; bf16x2_t b = __builtin_convertvector(v, bf16x2_t); return __builtin_bit_cast(unsigned, b); }
DI float bf2f(unsigned short h) { return __uint_as_float(((unsigned)h) << 16); }
DI float bflo(unsigned w) { return __uint_as_float(w << 16); }
DI float bfhi(unsigned w) { return __uint_as_float(w & 0xffff0000u); }
DI int fresh_tid() { int t = threadIdx.x; asm volatile("" : "+v"(t)); return t; }
DI int fresh_tid2(int wv) { unsigned z_ = 0u; asm volatile("" : "+v"(z_)); const int l_ = (int)__builtin_amdgcn_mbcnt_hi(~0u, __builtin_amdgcn_mbcnt_lo(~0u, z_)); return (wv << 6) | l_; }
DI LAS unsigned char* fresh_lds(LAS unsigned char* p) { asm volatile("" : "+s"(p)); return p; }
DI int fresh_s(int x) { asm volatile("" : "+s"(x)); return x; }
DI int perm32(int p) { return (p & 1) ? (p >> 1) + 16 : (p >> 1); }
DI int perm64(int p) { return p < 16 ? ((p & 1) ? (p >> 1) + 8 : (p >> 1)) : p; }
#define SWZ(v, x) __int_as_float(__builtin_amdgcn_ds_swizzle(__float_as_int(v), (((x) << 10) | 0x1f)))
DI float half_sum(float v) { auto rr = __builtin_amdgcn_permlane32_swap(__float_as_uint(v), __float_as_uint(v), false, false); return __uint_as_float(rr[0]) + __uint_as_float(rr[1]); }
DI float half_max(float v) { auto rr = __builtin_amdgcn_permlane32_swap(__float_as_uint(v), __float_as_uint(v), false, false); return fmaxf(__uint_as_float(rr[0]), __uint_as_float(rr[1])); }
DI float half_other(float v, int hi) { auto rr = __builtin_amdgcn_permlane32_swap(__float_as_uint(v), __float_as_uint(v), false, false); return __uint_as_float(hi ? rr[0] : rr[1]); }
DI float wave_sum(float v) {
    v += SWZ(v, 1); v += SWZ(v, 2); v += SWZ(v, 4); v += SWZ(v, 8); v += SWZ(v, 16);
    return half_sum(v);
}
DI void rope_cs(int pos, float inv_freq, float& c, float& s) {
    const float ang = (float)pos * inv_freq;
    double rev = (double)ang * 0.15915494309189535; rev -= __builtin_rint(rev);
    const float r = (float)rev; c = __builtin_amdgcn_cosf(r); s = __builtin_amdgcn_sinf(r);
}
DI float inv_freq_of(int i, float inv_half) { return exp2f(-(float)i * inv_half * 18.931568569324174f); }

namespace pg8 {
constexpr int BM = 256, BK = 64, HALF = 128, HTB = HALF * BK * 2, STAGE_BYTES = 8 * HTB, NXCD = 8, WGM = 4;
DI int lds_byte(int r, int c) { const int st = (r >> 4) * 2 + (c >> 5), rr = r & 15, cc = c & 31, ob = rr * 64 + cc * 2; return st * 1024 + (ob ^ (((ob >> 9) & 1) << 5)); }
DI void stage_rc(int b, int& R, int& C) { const int st = b / 1024, sb = b % 1024, swz = sb ^ (((sb >> 9) & 1) << 5); R = (st >> 1) * 16 + swz / 64; C = (st & 1) * 32 + (swz % 64) / 2; }
DI int perm32r(int rho) { const int n = rho >> 4, i = rho & 15; return 8 * (i >> 2) + 4 * n + (i & 3); }
struct Unit { int pm, pn; };
struct Gemm { const bf16_t* A; const bf16_t* Bt; int M, N, K, lda, ldb; };
struct StaticOrder {
    int nM, nN, nwg, G, c;
    DI void init(int M, int N, int G_, int c_) { nM = M / BM; nN = N / BM; nwg = nM * nN; G = G_; c = c_; }
    DI bool next(int i, Unit& u) const {
        const long L = (long)i * G + c; if (L >= nwg) return false;
        int wgid = (int)L; { const int q = nwg / NXCD, r = nwg % NXCD, xcd = wgid % NXCD, off = wgid / NXCD; wgid = (xcd < r ? xcd * (q + 1) : r * (q + 1) + (xcd - r) * q) + off; }
        const int nig = WGM * nN, gid = wgid / nig, fm = gid * WGM, gsz = (nM - fm) < WGM ? (nM - fm) : WGM;
        u.pm = fm + ((wgid % nig) % gsz); u.pn = (wgid % nig) / gsz; return true;
    }
};
typedef f32x4 Acc[2][2][4][2];

struct EpiSwiGLU {
    static constexpr bool PERM = true;
    bf16_t* O; int ldc;
    DI void operator()(const Acc& acc, const Unit& u, int wr, int wc, int fr, int fq) const {
        const int row0 = u.pm * BM + wr * 64 + fr, col0 = u.pn * HALF + wc * 32 + 8 * fq;
#pragma unroll
        for (int ai = 0; ai < 2; ++ai)
#pragma unroll
            for (int m = 0; m < 4; ++m) {
                bf16_t* rowp = O + (size_t)(row0 + ai * HALF + m * 16) * ldc + col0;
                float v[8];
#pragma unroll
                for (int n = 0; n < 2; ++n)
#pragma unroll
                    for (int i = 0; i < 4; ++i) { const float g = acc[ai][0][m][n][i], up = acc[ai][1][m][n][i]; v[n * 4 + i] = g * __builtin_amdgcn_rcpf(1.f + __expf(-g)) * up; }
                u32x4 w; w.x = cvtpk(v[0], v[1]); w.y = cvtpk(v[2], v[3]); w.z = cvtpk(v[4], v[5]); w.w = cvtpk(v[6], v[7]);
                *(u32x4*)rowp = w;
                asm volatile("" ::: "memory");
            }
    }
};
struct EpiResid {
    static constexpr bool PERM = false;
    const float* base; float* out; int ldc; float alpha;
    DI void operator()(const Acc& acc, const Unit& u, int wr, int wc, int fr, int fq) const {
        const int row0 = u.pm * BM + wr * 64 + fr, col0 = u.pn * BM + wc * 32 + 4 * fq;
#pragma unroll
        for (int ai = 0; ai < 2; ++ai) {
            f32x4 bv[4][2][2];
#pragma unroll
            for (int m = 0; m < 4; ++m) {
                const size_t off = (size_t)(row0 + ai * HALF + m * 16) * ldc + col0;
#pragma unroll
                for (int bj = 0; bj < 2; ++bj)
#pragma unroll
                    for (int n = 0; n < 2; ++n) bv[m][bj][n] = *(const f32x4*)(base + off + bj * HALF + n * 16);
            }
            asm volatile("" ::: "memory");
#pragma unroll
            for (int m = 0; m < 4; ++m) {
                const size_t off = (size_t)(row0 + ai * HALF + m * 16) * ldc + col0;
#pragma unroll
                for (int bj = 0; bj < 2; ++bj)
#pragma unroll
                    for (int n = 0; n < 2; ++n) *(f32x4*)(out + off + bj * HALF + n * 16) = bv[m][bj][n] + acc[ai][bj][m][n] * alpha;
            }
            asm volatile("" ::: "memory");
        }
    }
};
struct EpiF32 {
    static constexpr bool PERM = false;
    float* O; int ldc;
    DI void operator()(const Acc& acc, const Unit& u, int wr, int wc, int fr, int fq) const {
        const int row0 = u.pm * BM + wr * 64 + fr, col0 = u.pn * BM + wc * 32 + 4 * fq;
#pragma unroll
        for (int ai = 0; ai < 2; ++ai)
#pragma unroll
            for (int m = 0; m < 4; ++m) {
                const size_t off = (size_t)(row0 + ai * HALF + m * 16) * ldc + col0;
#pragma unroll
                for (int bj = 0; bj < 2; ++bj)
#pragma unroll
                    for (int n = 0; n < 2; ++n) *(f32x4*)(O + off + bj * HALF + n * 16) = acc[ai][bj][m][n];
                asm volatile("" ::: "memory");
            }
    }
};
template <int ACT> struct EpiBf16 {
    static constexpr bool PERM = true;
    bf16_t* O; int ldc; int ncols;
    DI void operator()(const Acc& acc, const Unit& u, int wr, int wc, int fr, int fq) const {
        const int row0 = u.pm * BM + wr * 64 + fr, col0 = u.pn * BM + wc * 32 + 8 * fq;
#pragma unroll
        for (int ai = 0; ai < 2; ++ai)
#pragma unroll
            for (int m = 0; m < 4; ++m) {
                bf16_t* rowp = O + (size_t)(row0 + ai * HALF + m * 16) * ldc + col0;
#pragma unroll
                for (int bj = 0; bj < 2; ++bj) {
                    if (col0 + bj * HALF >= ncols) continue;
                    float v[8];
#pragma unroll
                    for (int n = 0; n < 2; ++n)
#pragma unroll
                        for (int i = 0; i < 4; ++i) { float x = acc[ai][bj][m][n][i];
                            if (ACT == 2) { const float y = 0.7978845608028654f * (x + 0.044715f * x * x * x); x = x * __builtin_amdgcn_rcpf(1.f + __expf(-2.f * y)); }
                            v[n * 4 + i] = x; }
                    u32x4 w; w.x = cvtpk(v[0], v[1]); w.y = cvtpk(v[2], v[3]); w.z = cvtpk(v[4], v[5]); w.w = cvtpk(v[6], v[7]);
                    *(u32x4*)(rowp + bj * HALF) = w;
                }
                asm volatile("" ::: "memory");
            }
    }
};
template <class Epi>
DI void gemm_phase(LAS unsigned char* lds, const Gemm g, const StaticOrder& S, const Epi& E, int wv0) {
    const int tid = fresh_tid2(wv0), wid = __builtin_amdgcn_readfirstlane(tid >> 6), lane = tid & 63, wr = wid >> 2, wc = wid & 3, fr = lane & 15, fq = lane >> 4;
    const int K = g.K, nt = K / BK;
    unsigned voffA[2], voffB[2];
#pragma unroll
    for (int i = 0; i < 2; ++i) { int R, C; stage_rc(tid * 16 + i * 8192, R, C); const int Rb = Epi::PERM ? ((R & ~31) + perm32r(R & 31)) : R;
        voffA[i] = (unsigned)(R * g.lda + C) * 2u; voffB[i] = (unsigned)(Rb * g.ldb + C) * 2u; }
    const size_t kstep = (size_t)(BK * 2);
    const size_t hstepA = (size_t)HALF * g.lda * 2, hstepB = (size_t)HALF * g.ldb * 2;
    const size_t tstepA = 2 * hstepA, tstepB = 2 * hstepB;
    const unsigned ldsw = (unsigned)wid * 1024u;
    const int aoff = lds_byte(wr * 64 + fr, fq * 8), boff = lds_byte(wc * 32 + fr, fq * 8);
#define PG8_SA(b, h) (((b) * 2 + (h)) * HTB)
#define PG8_SB(b, h) ((4 + (b) * 2 + (h)) * HTB)
#define PG8_STAGE(bufoff, gbase, voff) do { _Pragma("unroll") for (int _i = 0; _i < 2; ++_i) \
        __builtin_amdgcn_global_load_lds((const unsigned*)((const char*)(gbase) + (voff)[_i]), (LAS unsigned*)(lds + (bufoff) + ldsw + _i * 8192), 16, 0, 0); } while (0)
#define PG8_LDA(dst, b, h) do { _Pragma("unroll") for (int m = 0; m < 4; ++m) _Pragma("unroll") for (int k = 0; k < 2; ++k) dst[m][k] = *(const LAS bf16x8*)(lds + PG8_SA(b, h) + aoff + m * 2048 + k * 1024); } while (0)
#define PG8_LDB(dst, b, h) do { _Pragma("unroll") for (int n = 0; n < 2; ++n) _Pragma("unroll") for (int k = 0; k < 2; ++k) dst[n][k] = *(const LAS bf16x8*)(lds + PG8_SB(b, h) + boff + n * 2048 + k * 1024); } while (0)
#define PG8_MMA(ai, bj, At, Bt) do { __builtin_amdgcn_s_setprio(1); _Pragma("unroll") for (int m = 0; m < 4; ++m) _Pragma("unroll") for (int n = 0; n < 2; ++n) _Pragma("unroll") for (int k = 0; k < 2; ++k) \
        acc[ai][bj][m][n] = __builtin_amdgcn_mfma_f32_16x16x32_bf16(Bt[n][k], At[m][k], acc[ai][bj][m][n], 0, 0, 0); __builtin_amdgcn_s_setprio(0); } while (0)
#define PG8_WAIT_V(n) asm volatile("s_waitcnt vmcnt(" #n ")" ::: "memory")
#define PG8_WAIT_L(n) asm volatile("s_waitcnt lgkmcnt(" #n ")" ::: "memory")
#define PG8_BAR __builtin_amdgcn_s_barrier()
#define PG8_SCHED __builtin_amdgcn_sched_barrier(0)
    Unit cur, nxt; int ui = 0;
    if (!S.next(0, cur)) return;
    Acc acc;
#pragma unroll
    for (int a = 0; a < 2; ++a)
#pragma unroll
        for (int b = 0; b < 2; ++b)
#pragma unroll
            for (int m = 0; m < 4; ++m)
#pragma unroll
                for (int n = 0; n < 2; ++n) acc[a][b][m][n] = (f32x4){0.f, 0.f, 0.f, 0.f};
    bf16x8 At[4][2], B0[2][2], B1[2][2];
    const char* cA = (const char*)g.A + (size_t)cur.pm * tstepA; const char* cB = (const char*)g.Bt + (size_t)cur.pn * tstepB;
    PG8_STAGE(PG8_SB(0, 0), cB, voffB); PG8_STAGE(PG8_SB(0, 1), cB + hstepB, voffB); PG8_STAGE(PG8_SA(0, 0), cA, voffA); PG8_STAGE(PG8_SA(0, 1), cA + hstepA, voffA);
    if (wr == 1) PG8_BAR;
    PG8_WAIT_V(2); PG8_BAR;
    PG8_STAGE(PG8_SB(1, 0), cB + kstep, voffB); PG8_STAGE(PG8_SA(1, 0), cA + kstep, voffA); PG8_STAGE(PG8_SB(1, 1), cB + hstepB + kstep, voffB);
    PG8_WAIT_V(6); PG8_BAR;
    for (;;) {
        const bool has_next = S.next(ui + 1, nxt);
        const char* nA = has_next ? (const char*)g.A + (size_t)nxt.pm * tstepA : cA; const char* nB = has_next ? (const char*)g.Bt + (size_t)nxt.pn * tstepB : cB;
        for (int t = 0; t < nt; t += 2) {
            const bool last = (t == nt - 2);
            const char* a1 = cA + (size_t)(t + 1) * kstep;
            const char* a2 = last ? nA : cA + (size_t)(t + 2) * kstep; const char* b2 = last ? nB : cB + (size_t)(t + 2) * kstep;
            const char* a3 = a2 + kstep; const char* b3 = b2 + kstep;
            PG8_LDB(B0, 0, 0); PG8_LDB(B1, 0, 1); PG8_SCHED; PG8_LDA(At, 0, 0); PG8_STAGE(PG8_SA(1, 1), a1 + hstepA, voffA);
            PG8_WAIT_V(8); PG8_WAIT_L(0); PG8_BAR; PG8_MMA(0, 0, At, B0); PG8_MMA(0, 1, At, B1); PG8_BAR; PG8_SCHED;
            PG8_LDA(At, 0, 1); PG8_STAGE(PG8_SB(0, 0), b2, voffB); PG8_STAGE(PG8_SB(0, 1), b2 + hstepB, voffB); PG8_STAGE(PG8_SA(0, 0), a2, voffA);
            PG8_WAIT_V(8); PG8_WAIT_L(0); PG8_BAR; PG8_MMA(1, 0, At, B0); PG8_MMA(1, 1, At, B1); PG8_BAR; PG8_SCHED;
            PG8_LDB(B0, 1, 0); PG8_LDB(B1, 1, 1); PG8_SCHED; PG8_LDA(At, 1, 0); PG8_STAGE(PG8_SA(0, 1), a2 + hstepA, voffA);
            PG8_WAIT_V(8); PG8_WAIT_L(0); PG8_BAR; PG8_MMA(0, 0, At, B0); PG8_MMA(0, 1, At, B1); PG8_BAR; PG8_SCHED;
            PG8_LDA(At, 1, 1); PG8_STAGE(PG8_SB(1, 0), b3, voffB); PG8_STAGE(PG8_SB(1, 1), b3 + hstepB, voffB); PG8_STAGE(PG8_SA(1, 0), a3, voffA);
            PG8_WAIT_V(8); PG8_WAIT_L(0); PG8_BAR; PG8_MMA(1, 0, At, B0); PG8_MMA(1, 1, At, B1); PG8_BAR; PG8_SCHED;
        }
        if (wr == 0) PG8_BAR;
        { const int l2_ = fresh_tid2(wv0) & 63; E(acc, cur, wr, wc, l2_ & 15, l2_ >> 4); }
        if (!has_next) break;
#pragma unroll
        for (int a = 0; a < 2; ++a)
#pragma unroll
            for (int b = 0; b < 2; ++b)
#pragma unroll
                for (int m = 0; m < 4; ++m)
#pragma unroll
                    for (int n = 0; n < 2; ++n) acc[a][b][m][n] = (f32x4){0.f, 0.f, 0.f, 0.f};
        cur = nxt; cA = nA; cB = nB; ++ui;
        if (wr == 1) PG8_BAR;
    }
    PG8_WAIT_V(0);
    PG8_BAR;
#undef PG8_SA
#undef PG8_SB
#undef PG8_STAGE
#undef PG8_LDA
#undef PG8_LDB
#undef PG8_MMA
#undef PG8_WAIT_V
#undef PG8_WAIT_L
#undef PG8_BAR
#undef PG8_SCHED
}
}

struct FGU { const float* wg; const float* wu; DI float operator()(int n, int k) const { const int pn = n >> 8, j = n & 255; const long d = (j < 128) ? 0 : (wu - wg); return wg[(long)k * DFF + pn * 128 + (j & 127) + d]; } };
struct FPlain { const float* w; int N; DI float operator()(int n, int k) const { return w[(size_t)k * N + n]; } };
DI int win_src_col(int d) {
    if (d >= DIN) return -1;
    if (d >= PC_GATE) return 1568 + (d - PC_GATE);
    if (d >= PC_SBQ) return d + 18;
    if (d < PC_KR) return d;
    if (d < PC_NQ) return PC_KR + perm32(d - PC_KR);
    const int e = d - PC_NQ, hd = e >> 6, p = e & 63;
    const bool roped = hd < 8 || hd == 10 || hd == 11 || hd == 14 || hd == 15;
    return PC_NQ + hd * 64 + (roped ? perm64(p) : p);
}
struct FWin { const float* w; DI float operator()(int n, int k) const { const int c = win_src_col(n); return c < 0 ? 0.f : w[(size_t)k * DIN + c]; } };
struct FUq { const float* w; DI float operator()(int n, int k) const { if (n >= 576) return 0.f; const int h = n / 96, j = n % 96; const int c = h * 96 + (j < 64 ? j : 64 + perm32(j - 64)); return w[(size_t)k * 576 + c]; } };
struct FUkv { const float* w; DI float operator()(int n, int k) const { int c; if (n < 384) c = (n >> 6) * 128 + (n & 63); else c = ((n - 384) >> 6) * 128 + 64 + (n & 63); return w[(size_t)k * 768 + c]; } };
struct FC1 { const float* wk; const float* wv; DI float operator()(int n, int k) const { const int t = k >> 6, d = k & 63; const long off = (n < 128) ? (long)(t * 64 + perm64(d)) * 128 + n : (long)k * 128 + (n - 128) + (wv - wk); return wk[off]; } };
struct FC2 { const float* wk; const float* wv; DI float operator()(int n, int k) const {
    const bool isk = n < 64 && k < 128, isv = n >= 64 && n < 128 && k >= 128;
    const long off = isk ? (long)(k * 64 + perm64(n & 63)) : isv ? (long)((k - 128) * 64 + (n - 64)) + (wv - wk) : 0;
    const float v = wk[off]; return (isk || isv) ? v : 0.f; } };

template <class F>
DI void conv_matrix(const F& f, int K, int Nd, bf16_t* dst, LAS float* scr, int gw, int NGW, int lane) {
    const int nblk = Nd / 32, items = (K / 64) * nblk;
    for (int it = gw; it < items; it += NGW) {
        const int kb = it / nblk, nb = it % nblk, k0 = 64 * kb, n0 = 32 * nb;
float tmp_[32];
#pragma unroll
        for (int i = 0; i < 32; ++i) tmp_[i] = f(n0 + (lane & 31), k0 + 2 * i + (lane >> 5));
#pragma unroll
        for (int i = 0; i < 32; ++i) scr[(2 * i + (lane >> 5)) * 33 + (lane & 31)] = tmp_[i];
        asm volatile("s_waitcnt lgkmcnt(0)" ::: "memory");
        const int c = lane & 7;
#pragma unroll
        for (int j = 0; j < 4; ++j) { const int n = (lane >> 3) + 8 * j; const LAS float* s = scr + (8 * c) * 33 + n;
            u32x4 o; o.x = cvtpk(s[0 * 33], s[1 * 33]); o.y = cvtpk(s[2 * 33], s[3 * 33]); o.z = cvtpk(s[4 * 33], s[5 * 33]); o.w = cvtpk(s[6 * 33], s[7 * 33]);
            *(u32x4*)(dst + (size_t)(n0 + n) * K + k0 + 8 * c) = o; }
        asm volatile("s_waitcnt lgkmcnt(0)" ::: "memory");
    }
}

DI int crow(int r, int hi) { return (r & 3) + 8 * (r >> 2) + 4 * hi; }
#define MFMA32(a, b, c) __builtin_amdgcn_mfma_f32_32x32x16_bf16((a), (b), (c), 0, 0, 0)
DI bf16x8 pack8(const f32x16& x, int s) {
    u32x4 p; p.x = cvtpk(x[8 * s], x[8 * s + 1]); p.y = cvtpk(x[8 * s + 2], x[8 * s + 3]); p.z = cvtpk(x[8 * s + 4], x[8 * s + 5]); p.w = cvtpk(x[8 * s + 6], x[8 * s + 7]);
    return __builtin_bit_cast(bf16x8, p);
}
typedef short v4i16_t __attribute__((ext_vector_type(4)));
DI s16x4 vtr(const LAS unsigned char* p) { return __builtin_bit_cast(s16x4, __builtin_amdgcn_ds_read_tr16_b64_v4i16((LAS v4i16_t*)p)); }
constexpr int VP2 = 144;
constexpr int AT_K = 0, AT_V = 28672, AT_MISC = 49152;
DI bf16x8 vfrag(const LAS unsigned char* Vs, int lane, int d0, int kb, int s) {
    const int i16 = lane & 15, g = lane >> 4, blk = g & 1, hi = g >> 1;
    const LAS unsigned char* p = Vs + (32 * kb + 16 * s + 4 * hi + (i16 >> 2)) * VP2 + 64 * d0 + 32 * blk + 8 * (i16 & 3);
    const s16x4 lo = vtr(p), hh = vtr(p + 8 * VP2);
    return (bf16x8){lo[0], lo[1], lo[2], lo[3], hh[0], hh[1], hh[2], hh[3]};
}
DI void store_o(const f32x16 (&o)[2], bf16_t* dst_row, int hi) {
#pragma unroll
    for (int d0 = 0; d0 < 2; ++d0)
#pragma unroll
        for (int j = 0; j < 4; ++j) { u32x2 w; w.x = cvtpk(o[d0][4 * j], o[d0][4 * j + 1]); w.y = cvtpk(o[d0][4 * j + 2], o[d0][4 * j + 3]); *(u32x2*)(dst_row + 32 * d0 + 8 * j + 4 * hi) = w; }
}

enum { MODE_CAUSAL = 0, MODE_CMP = 1, MODE_SEL = 2, MODE_WIN = 3 };
template <int DQK, int MODE>
DI void flash_unit(LAS unsigned char* lds, int wv0, const bf16_t* Qp, int qpitch, const bf16_t* K1, int k1pitch, const bf16_t* K2, int k2pitch,
                   const bf16_t* Vp, int vpitch, int q0, int t0, int t1, float sc, u32x4 mw, float gate, f32x16 (&tot)[2], float* lse_out, const float* rope = nullptr) {
    constexpr int KP2 = (DQK + 8) * 2, NKS = DQK / 16, KBUF = 64 * KP2, VBUF = 64 * VP2;
    const int tid = fresh_tid2(wv0), lane = tid & 63, wid = wv0, r32 = lane & 31, hi = lane >> 5;
    const int qpos = q0 + 32 * wid + r32, qmin = q0 + 32 * wid, qmax = qmin + 31;
    bf16x8 qf[NKS];
#pragma unroll
    for (int ks = 0; ks < NKS; ++ks) qf[ks] = *(const bf16x8*)(Qp + (size_t)(32 * wid + r32) * qpitch + 16 * ks + 8 * hi);
    if (DQK == 96) {
#pragma unroll
        for (int ks = 4; ks < NKS; ++ks) {
            const int p0 = 8 * (ks - 4) + 4 * hi;
            const f32x4 c4 = *(const f32x4*)(rope + ROPE_MLA_COS + qpos * 16 + p0), s4 = *(const f32x4*)(rope + ROPE_MLA_SIN + qpos * 16 + p0);
            u32x4 w = __builtin_bit_cast(u32x4, qf[ks]);
#pragma unroll
            for (int k = 0; k < 4; ++k) { const float x1 = bflo(w[k]), x2 = bfhi(w[k]); w[k] = cvtpk(x1 * c4[k] - x2 * s4[k], x2 * c4[k] + x1 * s4[k]); }
            qf[ks] = __builtin_bit_cast(bf16x8, w);
        }
    }
#pragma unroll
    for (int ks = 0; ks < NKS; ++ks) asm volatile("" : "+v"(qf[ks]));
    f32x16 o[2]; o[0] = (f32x16){}; o[1] = (f32x16){};
    float mref = -1e30f, l = 0.f;
    const int srow = tid >> 3, sch = tid & 7, srow2 = tid >> 2, sch2 = tid & 3;
    u32x4 rk1, rk2 = (u32x4){}, rv;
#define FL_GLOAD(t) do { const size_t kv_ = (size_t)64 * (t); rk1 = *(const u32x4*)(K1 + (kv_ + srow) * k1pitch + sch * 8); \
        if (DQK == 96 && tid < 256) rk2 = *(const u32x4*)(K2 + (kv_ + srow2) * k2pitch + sch2 * 8); \
        rv = *(const u32x4*)(Vp + (kv_ + srow) * vpitch + sch * 8); } while (0)
#define FL_LSTORE(buf) do { *(LAS u32x4*)(lds + AT_K + (buf) * KBUF + srow * KP2 + sch * 16) = rk1; \
        if (DQK == 96 && tid < 256) *(LAS u32x4*)(lds + AT_K + (buf) * KBUF + srow2 * KP2 + 128 + sch2 * 16) = rk2; \
        *(LAS u32x4*)(lds + AT_V + (buf) * VBUF + srow * VP2 + sch * 16) = rv; } while (0)
    FL_GLOAD(t0);
    __syncthreads();
    FL_LSTORE(0);
    if (t0 + 1 < t1) FL_GLOAD(t0 + 1);
    __syncthreads();
    for (int t = t0; t < t1; ++t) {
        const int cur = (t - t0) & 1;
        const LAS unsigned char* Ks = lds + AT_K + cur * KBUF; const LAS unsigned char* Vs = lds + AT_V + cur * VBUF;
        bool active = true;
        if (MODE == MODE_CAUSAL || MODE == MODE_SEL || MODE == MODE_WIN) active = (64 * t <= qmax);
        if (MODE == MODE_WIN) active = active && (64 * t + 63 + 512 > qmin);
        if (MODE == MODE_CMP) active = (16 * (64 * t) + 31 <= qmax);
        if (active) {
            f32x16 s[2];
            bf16x8 ka[2][NKS]; s16x4 vlo[2][2][2], vhi[2][2][2];
            {
                const unsigned kaddr = (unsigned)(unsigned long)(lds + AT_K + cur * KBUF) + (unsigned)(r32 * KP2 + hi * 16);
                const unsigned vaddr = (unsigned)(unsigned long)(lds + AT_V + cur * VBUF) + (unsigned)((4 * hi + ((lane & 15) >> 2)) * VP2 + 32 * ((lane >> 4) & 1) + 8 * (lane & 3));
#pragma unroll
                for (int kb = 0; kb < 2; ++kb)
#pragma unroll
                    for (int ks = 0; ks < NKS; ++ks) asm volatile("ds_read_b128 %0, %1 offset:%2" : "=v"(ka[kb][ks]) : "v"(kaddr), "n"(kb * 32 * KP2 + ks * 32) : "memory");
#pragma unroll
                for (int s2 = 0; s2 < 2; ++s2)
#pragma unroll
                    for (int d0 = 0; d0 < 2; ++d0) {
                        asm volatile("ds_read_b64_tr_b16 %0, %1 offset:%2" : "=v"(vlo[0][s2][d0]) : "v"(vaddr), "n"(16 * s2 * VP2 + 64 * d0) : "memory");
                        asm volatile("ds_read_b64_tr_b16 %0, %1 offset:%2" : "=v"(vhi[0][s2][d0]) : "v"(vaddr), "n"(16 * s2 * VP2 + 64 * d0 + 8 * VP2) : "memory");
                    }
                asm volatile("s_waitcnt lgkmcnt(8)" ::: "memory");
#pragma unroll
                for (int kb = 0; kb < 2; ++kb)
#pragma unroll
                    for (int ks = 0; ks < NKS; ++ks) asm volatile("" : "+v"(ka[kb][ks]));
                s[0] = (f32x16){}; s[1] = (f32x16){};
                __builtin_amdgcn_s_setprio(1);
#pragma unroll
                for (int ks = 0; ks < NKS; ++ks) { s[0] = MFMA32(ka[0][ks], qf[ks], s[0]); s[1] = MFMA32(ka[1][ks], qf[ks], s[1]); }
                __builtin_amdgcn_s_setprio(0);
#pragma unroll
                for (int s2 = 0; s2 < 2; ++s2)
#pragma unroll
                    for (int d0 = 0; d0 < 2; ++d0) {
                        asm volatile("ds_read_b64_tr_b16 %0, %1 offset:%2" : "=v"(vlo[1][s2][d0]) : "v"(vaddr), "n"((32 + 16 * s2) * VP2 + 64 * d0) : "memory");
                        asm volatile("ds_read_b64_tr_b16 %0, %1 offset:%2" : "=v"(vhi[1][s2][d0]) : "v"(vaddr), "n"((32 + 16 * s2) * VP2 + 64 * d0 + 8 * VP2) : "memory");
                    }
            }
            bool need_mask;
            if (MODE == MODE_CMP) need_mask = true;
            else if (MODE == MODE_WIN) need_mask = (64 * t + 63 > qmin) || (64 * t + 512 <= qmax);
            else need_mask = (64 * t + 63 > qmin);
            if (need_mask) {
#pragma unroll
                for (int kb = 0; kb < 2; ++kb)
#pragma unroll
                    for (int i = 0; i < 16; ++i) {
                        const int kv = 64 * t + 32 * kb + crow(i, hi);
                        bool valid;
                        if (MODE == MODE_CMP) valid = (16 * kv + 31 <= qpos);
                        else if (MODE == MODE_WIN) valid = (kv <= qpos) && (kv + 512 > qpos);
                        else valid = kv <= qpos;
                        s[kb][i] = valid ? s[kb][i] : -INFINITY;
                    }
            }
            if (MODE == MODE_SEL) {
                const unsigned w = (t < 32) ? mw.x : (t < 64) ? mw.y : (t < 96) ? mw.z : mw.w; const bool selw = ((w >> (t & 31)) & 1u) != 0;
                if (!__all(selw)) {
#pragma unroll
                    for (int kb = 0; kb < 2; ++kb)
#pragma unroll
                        for (int i = 0; i < 16; ++i) s[kb][i] = selw ? s[kb][i] : -INFINITY;
                }
            }
            float mx = fmaxf(s[0][0], s[1][0]);
#pragma unroll
            for (int i = 1; i < 16; ++i) mx = fmaxf(fmaxf(mx, s[0][i]), s[1][i]);
            mx = half_max(mx);
            const float msc = mx * sc;
            if (__any(msc > mref + 8.f)) {
                const float mnew = fmaxf(mref, msc), alpha = __builtin_amdgcn_exp2f(mref - mnew);
                mref = mnew; l *= alpha;
#pragma unroll
                for (int i = 0; i < 16; ++i) { o[0][i] *= alpha; o[1][i] *= alpha; }
            }
            float ls = 0.f;
#pragma unroll
            for (int kb = 0; kb < 2; ++kb)
#pragma unroll
                for (int i = 0; i < 16; ++i) { const float p = __builtin_amdgcn_exp2f(__builtin_fmaf(s[kb][i], sc, -mref)); s[kb][i] = p; ls += p; }
            l += ls;
            {
                asm volatile("s_waitcnt lgkmcnt(0)" ::: "memory");
#pragma unroll
                for (int kb = 0; kb < 2; ++kb)
#pragma unroll
                    for (int s2 = 0; s2 < 2; ++s2)
#pragma unroll
                        for (int d0 = 0; d0 < 2; ++d0) { asm volatile("" : "+v"(vlo[kb][s2][d0]), "+v"(vhi[kb][s2][d0])); }
                __builtin_amdgcn_s_setprio(1);
#pragma unroll
                for (int kb = 0; kb < 2; ++kb)
#pragma unroll
                    for (int s2 = 0; s2 < 2; ++s2) {
                        const bf16x8 pf = pack8(s[kb], s2);
#pragma unroll
                        for (int d0 = 0; d0 < 2; ++d0) {
                            const s16x4 lo = vlo[kb][s2][d0], hh = vhi[kb][s2][d0];
                            const bf16x8 vfr = (bf16x8){lo[0], lo[1], lo[2], lo[3], hh[0], hh[1], hh[2], hh[3]};
                            o[d0] = MFMA32(vfr, pf, o[d0]);
                        }
                    }
                __builtin_amdgcn_s_setprio(0);
            }
        }
        if (t + 1 < t1) { FL_LSTORE(cur ^ 1); if (t + 2 < t1) FL_GLOAD(t + 2); }
        __syncthreads();
    }
#undef FL_GLOAD
#undef FL_LSTORE
    const float lt = half_sum(l);
    bool rowok = true;
    if (MODE == MODE_CMP) rowok = qpos >= 31;
    const float inv = (rowok && lt > 0.f) ? gate / lt : 0.f;
#pragma unroll
    for (int i = 0; i < 16; ++i) { tot[0][i] += o[0][i] * inv; tot[1][i] += o[1][i] * inv; }
    if (MODE == MODE_CMP && hi == 0) lse_out[32 * wid + r32] = rowok ? (mref + log2f(lt)) : INFINITY;
}

DI void sb_unit(LAS unsigned char* lds, int wv0, const bf16_t* Qp, const bf16_t* Kp, const bf16_t* Vp, int q0, f32x16 (&o)[2]) {
    constexpr int KP2 = 144, pitch = NPROJ;
    const int tid = fresh_tid2(wv0), lane = tid & 63, wid = wv0, r32 = lane & 31, hi = lane >> 5;
    const int qpos = q0 + 32 * wid + r32, qmax = q0 + 32 * wid + 31;
    LAS unsigned char* Ks = lds + AT_K; LAS unsigned char* Vs = lds + AT_V; volatile LAS int* flags = (volatile LAS int*)(lds + AT_MISC);
    bf16x8 qf[4];
#pragma unroll
    for (int ks = 0; ks < 4; ++ks) qf[ks] = *(const bf16x8*)(Qp + (size_t)(32 * wid + r32) * pitch + 16 * ks + 8 * hi);
#pragma unroll
    for (int ks = 0; ks < 4; ++ks) asm volatile("" : "+v"(qf[ks]));
    float R = 0.f; bool wdone = false;
    const int srow = tid >> 3, sch = tid & 7;
    u32x4 rk, rv;
    const int tlast = (q0 + 255) >> 6;
    auto gload = [&](int t) { const size_t kv = (size_t)64 * t; rk = *(const u32x4*)(Kp + (kv + srow) * pitch + sch * 8); rv = *(const u32x4*)(Vp + (kv + srow) * pitch + sch * 8); };
    gload(tlast);
    if (lane == 0) flags[wid] = 0;
    for (int t = tlast; t >= 0; --t) {
        __syncthreads();
        { int alld = 1;
#pragma unroll
          for (int w = 0; w < 8; ++w) alld &= flags[w];
          if (alld) break; }
        *(LAS u32x4*)(Ks + srow * KP2 + sch * 16) = rk;
        *(LAS u32x4*)(Vs + srow * VP2 + sch * 16) = rv;
        __syncthreads();
        if (t > 0) gload(t - 1);
        const bool active = (64 * t < qmax) && !wdone;
        if (!active) continue;
        f32x16 s[2];
#pragma unroll
        for (int kb = 0; kb < 2; ++kb) {
            s[kb] = (f32x16){};
#pragma unroll
            for (int ks = 0; ks < 4; ++ks) { const bf16x8 a = *(const LAS bf16x8*)(Ks + (32 * kb + r32) * KP2 + ks * 32 + hi * 16); s[kb] = MFMA32(a, qf[ks], s[kb]); }
        }
        f32x16 lr[2];
        float own[8];
#pragma unroll
        for (int kb = 0; kb < 2; ++kb)
#pragma unroll
            for (int i = 0; i < 16; ++i) {
                const int kv = 64 * t + 32 * kb + crow(i, hi);
                const float z = s[kb][i] * 0.125f;
                const float sp = fmaxf(z, 0.f) + __logf(1.f + __expf(-fabsf(z)));
                const bool strict = kv < qpos;
                lr[kb][i] = strict ? -sp : 0.f;
                s[kb][i] = strict ? (z - sp) : -1e30f;
            }
#pragma unroll
        for (int g = 0; g < 8; ++g) { const int kb = g >> 2, j = g & 3; own[g] = (lr[kb][4 * j] + lr[kb][4 * j + 1]) + (lr[kb][4 * j + 2] + lr[kb][4 * j + 3]); }
        float E[8], Od[8], T[8];
#pragma unroll
        for (int g = 0; g < 8; ++g) { const float oth = half_other(own[g], hi); E[g] = hi ? oth : own[g]; Od[g] = hi ? own[g] : oth; }
        T[7] = 0.f;
#pragma unroll
        for (int g = 6; g >= 0; --g) T[g] = T[g + 1] + (E[g + 1] + Od[g + 1]);
        const float tile_tot = T[0] + (E[0] + Od[0]);
#pragma unroll
        for (int g = 0; g < 8; ++g) {
            const int kb = g >> 2, j = g & 3;
            const float sg = (hi ? T[g] : T[g] + Od[g]) + R;
            const float l3 = lr[kb][4 * j + 3], l2 = lr[kb][4 * j + 2], l1 = lr[kb][4 * j + 1];
            const float su3 = sg, su2 = sg + l3, su1 = su2 + l2, su0 = su1 + l1;
            s[kb][4 * j + 3] = exp2f((s[kb][4 * j + 3] + su3) * LOG2E);
            s[kb][4 * j + 2] = exp2f((s[kb][4 * j + 2] + su2) * LOG2E);
            s[kb][4 * j + 1] = exp2f((s[kb][4 * j + 1] + su1) * LOG2E);
            s[kb][4 * j + 0] = exp2f((s[kb][4 * j + 0] + su0) * LOG2E);
        }
        R += tile_tot;
#pragma unroll
        for (int kb = 0; kb < 2; ++kb)
#pragma unroll
            for (int s2 = 0; s2 < 2; ++s2) {
                const bf16x8 pf = pack8(s[kb], s2);
#pragma unroll
                for (int d0 = 0; d0 < 2; ++d0) { const bf16x8 vf = vfrag(Vs, lane, d0, kb, s2); o[d0] = MFMA32(vf, pf, o[d0]); }
            }
        if (!__any(R >= -104.f)) { wdone = true; if (lane == 0) flags[wid] = 1; }
    }
    if (lane == 0) flags[wid] = 1;
}


#define XB_TMO      128
#define XB_XCNT(j)  (256  + 64 * (j))
#define XB_XSUB(j)  (1280 + 64 * (j))
#define XB_XGEN(j)  (2304 + 64 * (j))
#define XB_TOP      3328
#define XB_TOPGEN   3392
#define XCD_BAR_WORDS 3456
#define XB_SPIN_CAP (1u << 18)
DI unsigned xb_ld(unsigned* p)              { return __hip_atomic_load(p, __ATOMIC_RELAXED, __HIP_MEMORY_SCOPE_AGENT); }
DI unsigned xb_add(unsigned* p, unsigned v) { return __hip_atomic_fetch_add(p, v, __ATOMIC_RELAXED, __HIP_MEMORY_SCOPE_AGENT); }
DI unsigned xb_xcc_id() { return (unsigned)__builtin_amdgcn_s_getreg((3 << 11) | 20) & 0xFu; }
#define XB_SPIN(cond, bar) do { unsigned _sp = 0; while (cond) { __builtin_amdgcn_s_sleep(1); \
    if ((++_sp & 255u) == 0u) { if (xb_ld(&(bar)[XB_TMO])) break; if (_sp > XB_SPIN_CAP) { atomicAdd(&(bar)[XB_TMO], 1u); break; } } } } while (0)
struct XcdBarrier { unsigned* bar; unsigned x; volatile LAS unsigned* st; };
DI void xcd_barrier_complete(unsigned* bar, unsigned x, unsigned& nloc, unsigned& nx) {
    const unsigned G = gridDim.x * gridDim.y * gridDim.z;
    unsigned sum, cnt, mine, sp = 0u;
    for (;;) {
        sum = 0u; cnt = 0u; mine = 0u;
#pragma unroll
        for (unsigned j = 0; j < 16; ++j) { const unsigned c = xb_ld(&bar[XB_XCNT(j)]); sum += c; cnt += (c > 0u) ? 1u : 0u; mine = (j == x) ? c : mine; }
        if (sum == G) break;
        __builtin_amdgcn_s_sleep(1);
        if ((++sp & 255u) == 0u) { if (xb_ld(&bar[XB_TMO])) break; if (sp > XB_SPIN_CAP) { atomicAdd(&bar[XB_TMO], 1u); break; } }
    }
    nloc = mine > 0u ? mine : 1u; nx = cnt > 0u ? cnt : 1u;
}
DI void xcd_barrier(const XcdBarrier& b) {
    asm volatile("s_waitcnt vmcnt(0)" ::: "memory");
    __syncthreads();
    if (threadIdx.x == 0) {
        unsigned* bar = b.bar;
        __builtin_amdgcn_s_waitcnt(0);
        unsigned nloc = b.st[0], nx = b.st[1];
        if (nloc == 0u) { xcd_barrier_complete(bar, b.x, nloc, nx); b.st[0] = nloc; b.st[1] = nx; }
        const unsigned old = xb_add(&bar[XB_XSUB(b.x)], 1u);
        const unsigned gen = old / nloc;
        if (old + 1u == (gen + 1u) * nloc) {
            __builtin_amdgcn_fence(__ATOMIC_RELEASE, "agent");
            asm volatile("s_waitcnt vmcnt(0)" ::: "memory");
            const unsigned og = xb_add(&bar[XB_TOP], 1u);
            const unsigned tg = og / nx;
            if (og + 1u == (tg + 1u) * nx) xb_add(&bar[XB_TOPGEN], 1u);
            else XB_SPIN(xb_ld(&bar[XB_TOPGEN]) == tg, bar);
            __builtin_amdgcn_fence(__ATOMIC_ACQUIRE, "agent");
            xb_add(&bar[XB_XGEN(b.x)], 1u);
            asm volatile("s_waitcnt vmcnt(0)" ::: "memory");
        } else {
            XB_SPIN(xb_ld(&bar[XB_XGEN(b.x)]) == gen, bar);
            __builtin_amdgcn_fence(__ATOMIC_ACQUIRE, "agent");
            asm volatile("s_waitcnt vmcnt(0)" ::: "memory");
        }
    }
    __syncthreads();
}
constexpr int BAR_WORD0 = 4096;
constexpr int LDS_BARST = 131072 + 32;

DI const float* gptr(LAS unsigned char* lds, int i);
DI void gsync(LAS unsigned char* lds) {
    XcdBarrier b; b.bar = (unsigned*)gptr(lds, 25) + BAR_WORD0; b.x = xb_xcc_id(); b.st = (volatile LAS unsigned*)(lds + LDS_BARST);
    xcd_barrier(b);
}
DI void gsync_cg(cg::grid_group& grid) {
    asm volatile("s_waitcnt vmcnt(0) lgkmcnt(0)" ::: "memory");
    grid.sync();
    __builtin_amdgcn_fence(__ATOMIC_ACQUIRE, "agent");
    asm volatile("s_waitcnt vmcnt(0)" ::: "memory");
}
DI void norm_rows(const float* src, const float* gain, bf16_t* HN, int gw, int NGW, int lane) {
    for (int mrow_ = gw; mrow_ < MTOK * REP_NORM; mrow_ += NGW) {
        const int mrow = mrow_ & (MTOK - 1);
        const f32x4* xr = (const f32x4*)(src + (size_t)mrow * DM) + lane;
        f32x4 v[4]; float ss = 0.f;
#pragma unroll
        for (int j = 0; j < 4; ++j) { v[j] = xr[64 * j]; ss += (v[j].x * v[j].x + v[j].y * v[j].y) + (v[j].z * v[j].z + v[j].w * v[j].w); }
        const float r = rsqrtf(wave_sum(ss) * (1.f / DM) + EPS);
        u32x2* o8 = (u32x2*)(HN + (size_t)mrow * DM) + lane;
#pragma unroll
        for (int j = 0; j < 4; ++j) { const f32x4 gg = ((const f32x4*)gain)[lane + 64 * j]; u32x2 w; w.x = cvtpk(v[j].x * r * gg.x, v[j].y * r * gg.y); w.y = cvtpk(v[j].z * r * gg.z, v[j].w * r * gg.w); o8[64 * j] = w; }
    }
}
DI void conv_ffn(const float* wg, const float* wu, const float* wd, bf16_t* Wgu, bf16_t* Wd, LAS float* scr, int gw, int NGW, int lane) {
    conv_matrix(FGU{wg, wu}, DM, 2 * DFF, Wgu, scr, gw, NGW, lane);
    conv_matrix(FPlain{wd, DM}, DFF, DM, Wd, scr, gw, NGW, lane);
}
DI void ffn_gemms(LAS unsigned char* lds, cg::grid_group& grid, unsigned char* ws, const float* base, float* X, int G, int bid, int wv0) {
    bf16_t* Wgu = (bf16_t*)(ws + WS_WGU); bf16_t* Wd = (bf16_t*)(ws + WS_WD); bf16_t* HN = (bf16_t*)(ws + WS_HN); bf16_t* ACT = (bf16_t*)(ws + WS_R);
    for (int rep = 0; rep < REP_FFN; ++rep) {
    { pg8::Gemm g{HN, Wgu, MTOK, 2 * DFF, DM, DM, DM}; pg8::StaticOrder S; S.init(MTOK, 2 * DFF, G, bid); pg8::EpiSwiGLU E{ACT, DFF}; pg8::gemm_phase(lds, g, S, E, wv0); }
    gsync(lds);
    { pg8::Gemm g{ACT, Wd, MTOK, DM, DFF, DFF, DFF}; pg8::StaticOrder S; S.init(MTOK, DM, G, bid); pg8::EpiResid E{rep == 0 ? base : X, X, DM, rep == 0 ? 0.5f : 0.f}; pg8::gemm_phase(lds, g, S, E, wv0); }
    gsync(lds);
    }
}

struct Params {
    const float* in[24];
    float* out;
    unsigned char* ws;
};

DI const float* gptr(LAS unsigned char* lds, int i) {
    LAS unsigned char* b = lds + PTAB; asm volatile("" : "+v"(b));
    volatile LAS unsigned* p = (volatile LAS unsigned*)(b + 8 * i);
    const unsigned lo = __builtin_amdgcn_readfirstlane(p[0]), hi = __builtin_amdgcn_readfirstlane(p[1]);
    return (const float*)(((unsigned long long)hi << 32) | lo);
}
#define PIN(i) gptr(lds, (i))
#define GET_WS() ((unsigned char*)gptr(lds, 25))
#define GET_X() ((float*)gptr(lds, 24))
#define WSP(type, off) ((type*)(ws + (off)))
#define Wgu WSP(bf16_t, WS_WGU)
#define Wd WSP(bf16_t, WS_WD)
#define Win WSP(bf16_t, WS_WIN)
#define Wout WSP(bf16_t, WS_WOUT)
#define Wc1 WSP(bf16_t, WS_WC1)
#define Wuq WSP(bf16_t, WS_WUQ)
#define Wukv WSP(bf16_t, WS_WUKV)
#define Wc2 WSP(bf16_t, WS_WC2)
#define HN WSP(bf16_t, WS_HN)
#define ACT WSP(bf16_t, WS_R)
#define PROJ WSP(bf16_t, WS_R)
#define GATES WSP(float, WS_GATES)
#define MASKS WSP(unsigned, WS_MASK)
#define LSE WSP(float, WS_LSE)
#define HID WSP(bf16_t, WS_HID)
#define KCVC WSP(bf16_t, WS_KCVC)
#define QMLA WSP(bf16_t, WS_QMLA)
#define KVB WSP(bf16_t, WS_KVB)
#define OCMP WSP(bf16_t, WS_OCMP)
#define FLAT WSP(bf16_t, WS_FLAT)
#define S1 WSP(float, WS_S1)
#define S2 WSP(float, WS_S2)
#define PHASE_PTRS unsigned char* ws = GET_WS(); float* X = GET_X(); (void)ws; (void)X; const int G = fresh_s(G0), bid = fresh_s(bid0), NGW = G * 8; (void)NGW; const int tid = fresh_tid2(wv0), lane = tid & 63, wid = wv0, gw = bid * 8 + wid; (void)lane; (void)gw; \
    LAS float* scr = (LAS float*)(lds + wid * 8704); (void)scr; volatile LAS int* s_item = (volatile LAS int*)(lds + 131072); (void)s_item

__global__ void __launch_bounds__(512) mega_fwd(Params P) {
    extern __shared__ __attribute__((aligned(16))) unsigned char lds_raw[];
    LAS unsigned char* const lds0 = (LAS unsigned char*)lds_raw;
#define lds fresh_lds(lds0)
    cg::grid_group grid = cg::this_grid();
    { const int tid = threadIdx.x;
    if (tid < 24) *(LAS unsigned long long*)(lds + PTAB + 8 * tid) = (unsigned long long)P.in[tid];
    if (tid == 24) *(LAS unsigned long long*)(lds + PTAB + 8 * 24) = (unsigned long long)P.out;
    if (tid == 25) *(LAS unsigned long long*)(lds + PTAB + 8 * 25) = (unsigned long long)P.ws;
    if (tid == 26) { *(LAS unsigned*)(lds + LDS_BARST) = 0u; *(LAS unsigned*)(lds + LDS_BARST + 4) = 0u; }
    if (tid == 0) (void)xb_add((unsigned*)P.ws + BAR_WORD0 + XB_XCNT(xb_xcc_id()), 1u); }
    __syncthreads();
    gsync_cg(grid);
    const int G0 = gridDim.x, bid0 = blockIdx.x;
    int wv0 = __builtin_amdgcn_readfirstlane((int)threadIdx.x >> 6); asm volatile("" : "+s"(wv0));

    for (int L = 0; L < 2; ++L) {
        { PHASE_PTRS; const float* xin = (L == 0) ? PIN(0) : X;
        norm_rows(xin, PIN(1) + L * DM, HN, gw, NGW, lane);
        if (L == 0) {
            float* rt = WSP(float, WS_ROPE);
            for (int idx = gw * 64 + lane; idx < 8192 * 16; idx += NGW * 64) { const int pos = idx >> 4, i = idx & 15; float c, sn; rope_cs(pos, inv_freq_of(i, 1.f / 16.f), c, sn); rt[ROPE_MLA_COS + idx] = c; rt[ROPE_MLA_SIN + idx] = sn; }
            for (int idx = gw * 64 + lane; idx < 8192 * 8; idx += NGW * 64) { const int pos = idx >> 3, i = idx & 7; float c, sn; rope_cs(pos, inv_freq_of(i, 1.f / 8.f), c, sn); rt[ROPE_NSA_COS + idx] = c; rt[ROPE_NSA_SIN + idx] = sn; }
        }
        for (int rep = 0; rep < REP_CONV; ++rep) {
        conv_ffn(PIN(2) + (size_t)L * DM * DFF, PIN(3) + (size_t)L * DM * DFF, PIN(4) + (size_t)L * DFF * DM, Wgu, Wd, scr, gw, NGW, lane);
        conv_matrix(FWin{PIN(6) + (size_t)L * DM * DIN}, DM, NPROJ, Win, scr, gw, NGW, lane);
        conv_matrix(FPlain{PIN(18) + (size_t)L * DM * DM, DM}, DM, DM, Wout, scr, gw, NGW, lane);
        conv_matrix(FUq{PIN(8) + (size_t)L * 256 * 576}, 256, 768, Wuq, scr, gw, NGW, lane);
        conv_matrix(FUkv{PIN(10) + (size_t)L * 128 * 768}, 128, 768, Wukv, scr, gw, NGW, lane);
        conv_matrix(FC1{PIN(13) + (size_t)L * 2048 * 128, PIN(16) + (size_t)L * 2048 * 128}, 2048, 256, Wc1, scr, gw, NGW, lane);
        conv_matrix(FC2{PIN(14) + (size_t)L * 128 * 64, PIN(17) + (size_t)L * 128 * 64}, 256, 256, Wc2, scr, gw, NGW, lane); } }
        gsync(lds);
        { PHASE_PTRS; const float* xin = (L == 0) ? PIN(0) : X; ffn_gemms(lds, grid, ws, xin, X, G, bid, wv0); }
        { PHASE_PTRS;
        norm_rows(X, PIN(5) + L * DM, HN, gw, NGW, lane);
        conv_ffn(PIN(20) + (size_t)L * DM * DFF, PIN(21) + (size_t)L * DM * DFF, PIN(22) + (size_t)L * DFF * DM, Wgu, Wd, scr, gw, NGW, lane); }
        gsync(lds);
        for (int rep = 0; rep < REP_G2; ++rep) { PHASE_PTRS; pg8::Gemm g{HN, Win, MTOK, NPROJ, DM, DM, DM}; pg8::StaticOrder S; S.init(MTOK, NPROJ, G, bid); pg8::EpiBf16<0> E{PROJ, NPROJ, NPROJ}; pg8::gemm_phase(lds, g, S, E, wv0); }
        gsync(lds);
#ifndef X_NOPOST
        { PHASE_PTRS;
            const float* qn = PIN(7) + L * 256; const float* kvn = PIN(9) + L * 128; const float* gbias = PIN(11) + L * 18;
            const float* posk = PIN(12) + L * 2048; const float* posv = PIN(15) + L * 2048; const float* rt = WSP(float, WS_ROPE);
            if (gw < 8) {
                const size_t R = (gw < 4) ? (size_t)(2044 + gw) : (size_t)(2048 + 2044 + (gw - 4));
#pragma unroll
                for (int j = 0; j < 4; ++j) *(u32x4*)(FLAT + R * 2048 + (j * 64 + lane) * 8) = (u32x4){0u, 0u, 0u, 0u};
            }
            const f32x4 gq = ((const f32x4*)qn)[lane]; const f32x2 gkv = ((const f32x2*)kvn)[lane]; const float gb = lane < 18 ? gbias[lane] : 0.f;
            const int g_ = lane >> 5, pp = lane & 31;
            const int hdA = lane >> 3, iA = lane & 7, baseA = hdA < 6 ? PC_NQ + 64 * hdA : PC_KS + 64 * (hdA - 6);
            const int hdB = 8 + (lane >> 3), baseB = PC_KW + 64 * (hdB - 8);
            for (int mrow = gw; mrow < MTOK; mrow += NGW) {
                bf16_t* pr = PROJ + (size_t)mrow * NPROJ;
                const int b = mrow >> 13, spos = mrow & (SEQ - 1);
                const int j = spos >> 4, t16 = spos & 15;
                u32x2 wcq = *(const u32x2*)(pr + PC_CQ + 4 * lane);
                const unsigned wckv = *(const unsigned*)(pr + PC_CKV + 2 * lane);
                const unsigned wkr = *(const unsigned*)(pr + PC_KR + 2 * (lane & 15));
                const float ckr = rt[ROPE_MLA_COS + spos * 16 + (lane & 15)], skr = rt[ROPE_MLA_SIN + spos * 16 + (lane & 15)];
                const unsigned wA = *(const unsigned*)(pr + baseA + 2 * iA);
                const unsigned wB = *(const unsigned*)(pr + baseB + 2 * iA);
                const float cn = rt[ROPE_NSA_COS + spos * 8 + iA], sn = rt[ROPE_NSA_SIN + spos * 8 + iA];
                const float gatev = bf2f(pr[PC_GATE + (lane < 18 ? lane : 0)]);
                const unsigned wk = *(const unsigned*)(pr + PC_KC + 64 * g_ + 2 * pp);
                const unsigned wv = *(const unsigned*)(pr + PC_VC + 64 * g_ + 2 * pp);
                const float ck = rt[ROPE_NSA_COS + spos * 8 + (pp & 7)], sk = rt[ROPE_NSA_SIN + spos * 8 + (pp & 7)];
                const float pk00 = posk[t16 * 64 + perm64(2 * pp)], pk01 = posk[t16 * 64 + perm64(2 * pp + 1)];
                const float pk10 = posk[(16 + t16) * 64 + perm64(2 * pp)], pk11 = posk[(16 + t16) * 64 + perm64(2 * pp + 1)];
                const f32x2 pv0 = *(const f32x2*)(posv + t16 * 64 + 2 * pp), pv1 = *(const f32x2*)(posv + (16 + t16) * 64 + 2 * pp);
                { const float a0 = bflo(wcq.x), a1 = bfhi(wcq.x), a2 = bflo(wcq.y), a3 = bfhi(wcq.y);
                  const float b0 = bflo(wckv), b1 = bfhi(wckv);
                  const float r = rsqrtf(wave_sum((a0 * a0 + a1 * a1) + (a2 * a2 + a3 * a3)) * (1.f / 256.f) + EPS);
                  const float r2 = rsqrtf(wave_sum(b0 * b0 + b1 * b1) * (1.f / 128.f) + EPS);
                  wcq.x = cvtpk(a0 * r * gq.x, a1 * r * gq.y); wcq.y = cvtpk(a2 * r * gq.z, a3 * r * gq.w);
                  *(u32x2*)(pr + PC_CQ + 4 * lane) = wcq;
                  *(unsigned*)(pr + PC_CKV + 2 * lane) = cvtpk(b0 * r2 * gkv.x, b1 * r2 * gkv.y); }
                if (lane < 16) { const float x1 = bflo(wkr), x2 = bfhi(wkr); *(unsigned*)(pr + PC_KR + 2 * lane) = cvtpk(x1 * ckr - x2 * skr, x2 * ckr + x1 * skr); }
                { const float x1 = bflo(wA), x2 = bfhi(wA); *(unsigned*)(pr + baseA + 2 * iA) = cvtpk(x1 * cn - x2 * sn, x2 * cn + x1 * sn); }
                if (lane < 16) { const float x1 = bflo(wB), x2 = bfhi(wB); *(unsigned*)(pr + baseB + 2 * iA) = cvtpk(x1 * cn - x2 * sn, x2 * cn + x1 * sn); }
                if (lane < 18) GATES[(size_t)mrow * 32 + lane] = 1.f / (1.f + __expf(-(gatev + gb)));
                {
                    float k0 = bflo(wk), k1 = bfhi(wk);
                    if (pp < 8) { const float x1 = k0, x2 = k1; k0 = x1 * ck - x2 * sk; k1 = x2 * ck + x1 * sk; }
                    const float v0 = bflo(wv), v1 = bfhi(wv);
                    if (j < NCMP) { const size_t R = (size_t)(b * NCMP + j) * 2 + g_;
                        *(unsigned*)(FLAT + R * 2048 + t16 * 64 + 2 * pp) = cvtpk(k0 + pk00, k1 + pk01);
                        *(unsigned*)(FLAT + (2048 + R) * 2048 + t16 * 64 + 2 * pp) = cvtpk(v0 + pv0.x, v1 + pv0.y); }
                    if (j >= 1) { const size_t R = (size_t)(b * NCMP + j - 1) * 2 + g_;
                        *(unsigned*)(FLAT + R * 2048 + (16 + t16) * 64 + 2 * pp) = cvtpk(k0 + pk10, k1 + pk11);
                        *(unsigned*)(FLAT + (2048 + R) * 2048 + (16 + t16) * 64 + 2 * pp) = cvtpk(v0 + pv1.x, v1 + pv1.y); }
                }
            }
        }
#endif
        gsync(lds);
        for (int rep = 0; rep < REP_G2; ++rep) {
        { PHASE_PTRS; pg8::Gemm g{PROJ + PC_CQ, Wuq, MTOK, 768, 256, NPROJ, 256}; pg8::StaticOrder S; S.init(MTOK, 768, G, bid); pg8::EpiBf16<0> E{QMLA, 576, 576}; pg8::gemm_phase(lds, g, S, E, wv0); }
        { PHASE_PTRS; pg8::Gemm g{PROJ + PC_CKV, Wukv, MTOK, 768, 128, NPROJ, 128}; pg8::StaticOrder S; S.init(MTOK, 768, G, bid); pg8::EpiBf16<0> E{KVB, 768, 768}; pg8::gemm_phase(lds, g, S, E, wv0); }
        for (int ks = 0; ks < 4; ++ks) {
            PHASE_PTRS; pg8::Gemm g{FLAT + ks * 512, Wc1 + ks * 512, 4096, 256, 512, 2048, 2048}; pg8::StaticOrder S; S.init(4096, 256, G, (bid + G - 128 - 16 * ks) % G);
            pg8::EpiF32 E{WSP(float, WS_PART) + (size_t)ks * 4096 * 256, 256}; pg8::gemm_phase(lds, g, S, E, wv0); } }
        gsync(lds);
        { PHASE_PTRS;
            const f32x4* part = (const f32x4*)WSP(float, WS_PART);
            for (int e = bid * 512 + tid; e < 4096 * 64; e += G * 512) {
                f32x4 a = part[e] + part[e + (size_t)4096 * 64] + part[e + (size_t)2 * 4096 * 64] + part[e + (size_t)3 * 4096 * 64];
#pragma unroll
                for (int i = 0; i < 4; ++i) { const float x = a[i], y = 0.7978845608028654f * (x + 0.044715f * x * x * x); a[i] = x * __builtin_amdgcn_rcpf(1.f + __expf(-2.f * y)); }
                u32x2 w; w.x = cvtpk(a[0], a[1]); w.y = cvtpk(a[2], a[3]);
                *(u32x2*)(HID + (size_t)e * 4) = w;
            }
        }
        gsync(lds);
        { PHASE_PTRS; pg8::Gemm g{HID, Wc2, 4096, 256, 256, 256, 256}; pg8::StaticOrder S; S.init(4096, 256, G, bid); pg8::EpiBf16<0> E{KCVC, 256, 256}; pg8::gemm_phase(lds, g, S, E, wv0); }
        gsync(lds);
#ifndef X_NOA1
        { PHASE_PTRS;
            unsigned* ctr = WSP(unsigned, WS_CTL) + 64 * (1 + 2 * L);
            const int r32 = lane & 31, hi = lane >> 5;
            for (;;) {
                __syncthreads();
                if (tid == 0) *s_item = (int)atomicAdd(ctr, 1u);
                __syncthreads();
                const int it = *s_item;
                if (it >= 384) break;
                const int qb = 31 - it / 12, bh = it % 12, b = bh / 6, h = bh % 6, g = h / 3, q0 = qb * 256;
                const size_t rb = (size_t)b * SEQ;
                const int cmax = (q0 + 224) >> 4, t1 = (cmax >> 6) + 1;
                const float gate = GATES[(rb + q0 + 32 * wid + r32) * 32 + h * 3 + 0];
                f32x16 tot[2]; tot[0] = (f32x16){}; tot[1] = (f32x16){};
                flash_unit<64, MODE_CMP>(lds, wv0, PROJ + (rb + q0) * NPROJ + PC_NQ + 64 * h, NPROJ, KCVC + ((size_t)(b * NCMP) * 2 + g) * 256, 512, nullptr, 0,
                                         KCVC + ((size_t)2048 + (size_t)(b * NCMP) * 2 + g) * 256 + 64, 512, q0, 0, t1, 0.125f * LOG2E, (u32x4){}, gate, tot,
                                         LSE + (size_t)(b * 6 + h) * SEQ + q0);
                store_o(tot, OCMP + (rb + q0 + 32 * wid + r32) * 384 + h * 64, hi);
            }
        }
#endif
        gsync(lds);
#ifndef X_NOA2A
        { PHASE_PTRS;
            const int r32 = lane & 31, hi = lane >> 5;
            LAS unsigned char* Ks = lds + AT_K;
            for (int it_ = bid; it_ < 256 * REP_A2; it_ += G) {
                const int thalf = it_ & 1, it = (it_ >> 1) & 127;
                const int qb = it >> 2, b = (it >> 1) & 1, g = it & 1, q0 = qb * 256;
                const size_t rb = (size_t)b * SEQ;
                const int qpos = q0 + 32 * wid + r32, qmaxw = q0 + 32 * wid + 31;
                const int cmax = (q0 + 224) >> 4, t1 = (cmax >> 6) + 1;
                bf16x8 qf[3][4]; float lse[3];
#pragma unroll
                for (int r = 0; r < 3; ++r) {
                    const int h = 3 * g + r;
#pragma unroll
                    for (int ks = 0; ks < 4; ++ks) qf[r][ks] = *(const bf16x8*)(PROJ + (rb + qpos) * NPROJ + PC_NQ + 64 * h + 16 * ks + 8 * hi);
                    lse[r] = LSE[(size_t)(b * 6 + h) * SEQ + qpos];
                }
                const bf16_t* K1 = KCVC + ((size_t)(b * NCMP) * 2 + g) * 256;
                const int srow = tid >> 3, sch = tid & 7;
                float* s1row = S1 + ((size_t)(b * 2 + g) * SEQ + qpos) * 128; float* s2row = S2 + ((size_t)(b * 2 + g) * SEQ + qpos) * 128;
                for (int t = thalf; t < t1; t += 2) {
                    __syncthreads();
                    *(LAS u32x4*)(Ks + srow * 144 + sch * 16) = *(const u32x4*)(K1 + ((size_t)64 * t + srow) * 512 + sch * 8);
                    __syncthreads();
                    if (16 * (64 * t) + 31 > qmaxw) continue;
#pragma unroll
                    for (int kb = 0; kb < 2; ++kb) {
                        f32x16 ps = (f32x16){};
#pragma unroll
                        for (int r = 0; r < 3; ++r) {
                            f32x16 s = (f32x16){};
#pragma unroll
                            for (int ks = 0; ks < 4; ++ks) { const bf16x8 a = *(const LAS bf16x8*)(Ks + (32 * kb + r32) * 144 + ks * 32 + hi * 16); s = MFMA32(a, qf[r][ks], s); }
#pragma unroll
                            for (int i = 0; i < 16; ++i) { const int c = 64 * t + 32 * kb + crow(i, hi); const bool valid = (16 * c + 31 <= qpos); ps[i] += valid ? exp2f(s[i] * (0.125f * LOG2E) - lse[r]) : 0.f; }
                        }
#pragma unroll
                        for (int j = 0; j < 4; ++j) { const int n = 16 * t + 8 * kb + 2 * j + hi; s1row[n] = (ps[4 * j] + ps[4 * j + 1]) + (ps[4 * j + 2] + ps[4 * j + 3]); s2row[n] = ps[4 * j + 3]; }
                    }
                }
            }
        }
#endif
        gsync(lds);
#ifndef X_NOA2B
        { PHASE_PTRS;
#define TK_LOAD(IT, K0, K1) do { const int q_ = (IT) & (SEQ - 1), cur_ = q_ >> 6; K0 = 0u; K1 = 0u; \
            if (cur_ > 15) { const float* s1_ = S1 + (size_t)(IT) * 128; const float* s2_ = S2 + (size_t)(IT) * 128; \
                const bool c0_ = lane >= 1 && lane <= cur_ - 2, c1_ = lane + 64 <= cur_ - 2; \
                if (c0_) K0 = __float_as_uint(s1_[lane] + s2_[lane - 1]) + 1u; \
                if (c1_) K1 = __float_as_uint(s1_[lane + 64] + s2_[lane + 63]) + 1u; } } while (0)
            const int NIT = 2 * 2 * SEQ * REP_A2;
            for (int itA_ = gw; itA_ < NIT; itA_ += 2 * NGW) {
                const int itB_ = itA_ + NGW;
                const int itA = itA_ & (2 * 2 * SEQ - 1), itB = itB_ & (2 * 2 * SEQ - 1);
                const bool hasB = itB_ < NIT;
                unsigned a0 = 0u, a1 = 0u, c0 = 0u, c1 = 0u;
                TK_LOAD(itA, a0, a1);
                if (hasB) TK_LOAD(itB, c0, c1);
                const int curA = (itA & (SEQ - 1)) >> 6, curB = (itB & (SEQ - 1)) >> 6;
                unsigned TA = 0u, TB = 0u;
                for (int bit = 30; bit >= 0; --bit) {
                    const unsigned trA = TA | (1u << bit), trB = TB | (1u << bit);
                    const int cA = __popcll(__ballot(a0 >= trA)) + __popcll(__ballot(a1 >= trA));
                    const int cB = __popcll(__ballot(c0 >= trB)) + __popcll(__ballot(c1 >= trB));
                    if (cA >= 13) TA = trA;
                    if (cB >= 13) TB = trB;
                }
#define TK_FINISH(IT, CUR, K0, K1, T) do { unsigned long long b0_ = 0ull, b1_ = 0ull; \
                    if ((CUR) <= 15) { b0_ = (2ull << (CUR)) - 1ull; } \
                    else { b0_ = __ballot((K0) > (T)); b1_ = __ballot((K1) > (T)); int need_ = 13 - __popcll(b0_) - __popcll(b1_); \
                        unsigned long long e0_ = __ballot((K0) == (T)), e1_ = __ballot((K1) == (T)); \
                        while (need_ > 0) { if (e0_) { const unsigned long long low_ = e0_ & (0ull - e0_); b0_ |= low_; e0_ ^= low_; } \
                                            else { const unsigned long long low_ = e1_ & (0ull - e1_); b1_ |= low_; e1_ ^= low_; } --need_; } \
                        b0_ |= 1ull; \
                        if ((CUR) < 64) b0_ |= 1ull << (CUR); else b1_ |= 1ull << ((CUR) - 64); \
                        if ((CUR) - 1 < 64) b0_ |= 1ull << ((CUR) - 1); else b1_ |= 1ull << ((CUR) - 65); } \
                    if (lane == 0) *(u32x4*)(MASKS + (size_t)(IT) * 4) = (u32x4){(unsigned)b0_, (unsigned)(b0_ >> 32), (unsigned)b1_, (unsigned)(b1_ >> 32)}; } while (0)
                TK_FINISH(itA, curA, a0, a1, TA);
                if (hasB) TK_FINISH(itB, curB, c0, c1, TB);
#undef TK_FINISH
            }
#undef TK_LOAD
        }
#endif
        gsync(lds);
#ifndef X_NOA3
        { PHASE_PTRS;
            unsigned* ctr = WSP(unsigned, WS_CTL) + 64 * (2 + 2 * L);
            const int r32 = lane & 31, hi = lane >> 5;
            for (;;) {
                __syncthreads();
                if (tid == 0) *s_item = (int)atomicAdd(ctr, 1u);
                __syncthreads();
                const int it = *s_item;
                if (it >= 1024) break;
                if (it >= 768) {
                    const int k = it - 768, qb = 31 - k / 8, bh = k % 8, b = bh >> 2, h = bh & 3, q0 = qb * 256;
                    const size_t rb = (size_t)b * SEQ;
                    f32x16 tot[2]; tot[0] = (f32x16){}; tot[1] = (f32x16){};
                    sb_unit(lds, wv0, PROJ + (rb + q0) * NPROJ + PC_SBQ + 64 * h, PROJ + rb * NPROJ + PC_SBK + 64 * h, PROJ + rb * NPROJ + PC_SBV + 64 * h, q0, tot);
                    store_o(tot, HN + (rb + q0 + 32 * wid + r32) * DM + 768 + h * 64, hi);
                    continue;
                }
                const int qb = 31 - it / 24, r24 = it % 24, bh = r24 % 12, b = bh / 6, h = bh % 6, g = h / 3, q0 = qb * 256;
                const size_t rb = (size_t)b * SEQ; const size_t qrow = rb + q0 + 32 * wid + r32;
                if (r24 < 12) {
                    f32x16 tot[2]; tot[0] = (f32x16){}; tot[1] = (f32x16){};
                    flash_unit<96, MODE_CAUSAL>(lds, wv0, QMLA + (rb + q0) * 576 + h * 96, 576, KVB + rb * 768 + h * 64, 768, PROJ + rb * NPROJ + PC_KR, NPROJ,
                                                KVB + rb * 768 + 384 + h * 64, 768, q0, 0, (q0 + 256) / 64, 0.10206207261596577f * LOG2E, (u32x4){}, 1.f, tot, nullptr, WSP(float, WS_ROPE));
                    store_o(tot, HN + qrow * DM + h * 64, hi);
                } else {
                    const float g1 = GATES[qrow * 32 + h * 3 + 1], g2 = GATES[qrow * 32 + h * 3 + 2];
                    const u32x4 mw = *(const u32x4*)(MASKS + ((size_t)(b * 2 + g) * SEQ + q0 + 32 * wid + r32) * 4);
                    f32x16 tot[2];
                    { const bf16_t* oc = OCMP + qrow * 384 + h * 64;
#pragma unroll
                      for (int d0 = 0; d0 < 2; ++d0)
#pragma unroll
                          for (int j = 0; j < 4; ++j) { const u32x2 w = *(const u32x2*)(oc + 32 * d0 + 8 * j + 4 * hi); tot[d0][4 * j] = bflo(w.x); tot[d0][4 * j + 1] = bfhi(w.x); tot[d0][4 * j + 2] = bflo(w.y); tot[d0][4 * j + 3] = bfhi(w.y); } }
                    const bf16_t* Qp = PROJ + (rb + q0) * NPROJ + PC_NQ + 64 * h;
                    flash_unit<64, MODE_SEL>(lds, wv0, Qp, NPROJ, PROJ + rb * NPROJ + PC_KS + 64 * g, NPROJ, nullptr, 0, PROJ + rb * NPROJ + PC_VS + 64 * g, NPROJ,
                                             q0, 0, (q0 + 256) / 64, 0.125f * LOG2E, mw, g1, tot, nullptr);
                    const int tw0 = (q0 >= 512) ? (q0 - 512) / 64 : 0;
                    flash_unit<64, MODE_WIN>(lds, wv0, Qp, NPROJ, PROJ + rb * NPROJ + PC_KW + 64 * g, NPROJ, nullptr, 0, PROJ + rb * NPROJ + PC_VW + 64 * g, NPROJ,
                                             q0, tw0, (q0 + 256) / 64, 0.125f * LOG2E, (u32x4){}, g2, tot, nullptr);
                    store_o(tot, HN + qrow * DM + 384 + h * 64, hi);
                }
            }
        }
#endif
        gsync(lds);
        { PHASE_PTRS; pg8::Gemm g{HN, Wout, MTOK, DM, DM, DM, DM}; pg8::StaticOrder S; S.init(MTOK, DM, G, bid); pg8::EpiResid E{X, X, DM, 1.0f}; pg8::gemm_phase(lds, g, S, E, wv0); }
        gsync(lds);
        { PHASE_PTRS; norm_rows(X, PIN(19) + L * DM, HN, gw, NGW, lane); }
        gsync(lds);
        { PHASE_PTRS; ffn_gemms(lds, grid, ws, X, X, G, bid, wv0); }
    }
    float* X = GET_X(); const float* fng = PIN(23); const int G = fresh_s(G0), bid = fresh_s(bid0), NGW = G * 8;
    const int tid = fresh_tid2(wv0), lane = tid & 63, wid = wv0, gw = bid * 8 + wid;
    for (int mrow = gw; mrow < MTOK; mrow += NGW) {
        f32x4* xr = (f32x4*)(X + (size_t)mrow * DM) + lane;
        f32x4 v[4]; float ss = 0.f;
#pragma unroll
        for (int j = 0; j < 4; ++j) { v[j] = xr[64 * j]; ss += (v[j].x * v[j].x + v[j].y * v[j].y) + (v[j].z * v[j].z + v[j].w * v[j].w); }
        const float r = rsqrtf(wave_sum(ss) * (1.f / DM) + EPS);
#pragma unroll
        for (int j = 0; j < 4; ++j) { const f32x4 gg = ((const f32x4*)fng)[lane + 64 * j]; xr[64 * j] = v[j] * r * gg; }
    }
}

#undef lds
extern "C" void kernel_launch(void* const* d_in, const int* in_sizes, int n_in, void* d_out, int out_size, void* d_ws, size_t ws_size, hipStream_t stream) {
    static int grid = 0;
    if (grid == 0) {
        if (n_in != 24 || out_size != MTOK * DM || ws_size < WS_END) { fprintf(stderr, "kernel_launch: unexpected shapes (n_in %d out %d ws %zu)\n", n_in, out_size, ws_size); grid = -1; return; }
        int dev = 0, cus = 0, per_cu = 0;
        hipGetDevice(&dev);
        hipDeviceGetAttribute(&cus, hipDeviceAttributeMultiprocessorCount, dev);
        hipFuncSetAttribute((const void*)mega_fwd, hipFuncAttributeMaxDynamicSharedMemorySize, LDS_BYTES);
        hipOccupancyMaxActiveBlocksPerMultiprocessor(&per_cu, (const void*)mega_fwd, 512, LDS_BYTES);
        if (per_cu < 1) per_cu = 1;
        grid = cus * 1;
        (void)hipGetLastError();
    }
    if (grid < 0) return;
    hipMemsetAsync((char*)d_ws + WS_CTL, 0, 65536, stream);
    Params p{};
    for (int i = 0; i < 24; ++i) p.in[i] = (const float*)d_in[i];
    p.out = (float*)d_out; p.ws = (unsigned char*)d_ws;
    void* args[] = {&p};
    hipError_t e = hipLaunchCooperativeKernel((const void*)mega_fwd, dim3(grid), dim3(512), args, LDS_BYTES, stream);
    if (e != hipSuccess) fprintf(stderr, "cooperative launch failed: %s (grid %d)\n", hipGetErrorString(e), grid);
}
```

```cpp
#include <hip/hip_runtime.h>
#include <hip/hip_cooperative_groups.h>
#include <cstdio>
#include <cstdint>
namespace cg = cooperative_groups;
#ifndef GS_REP
#define GS_REP 1
#endif
#ifndef REP_A2
#define REP_A2 1
#endif
#ifndef REP_NORM
#define REP_NORM 1
#endif
#ifndef REP_G2
#define REP_G2 1
#endif
#ifndef REP_A1
#define REP_A1 1
#endif
#ifndef REP_A3
#define REP_A3 1
#endif
#ifndef REP_FFN
#define REP_FFN 1
#endif
#ifndef REP_CONV
#define REP_CONV 1
#endif

#define LAS __attribute__((address_space(3)))
typedef unsigned short bf16_t;
typedef short bf16x8 __attribute__((ext_vector_type(8)));
typedef short s16x4 __attribute__((ext_vector_type(4)));
typedef float f32x2 __attribute__((ext_vector_type(2)));
typedef float f32x4 __attribute__((ext_vector_type(4)));
typedef float f32x16 __attribute__((ext_vector_type(16)));
typedef unsigned u32x2 __attribute__((ext_vector_type(2)));
typedef unsigned u32x4 __attribute__((ext_vector_type(4)));
typedef __bf16 bf16x2_t __attribute__((ext_vector_type(2)));
#define DI __device__ __forceinline__

constexpr int SEQ = 8192, BATCH = 2, MTOK = BATCH * SEQ, DM = 1024, DFF = 2816, DIN = 2354, NPROJ = 2560;
constexpr int NCMP = 511;
constexpr float EPS = 1e-6f;
constexpr float LOG2E = 1.4426950408889634f;
constexpr int PC_CQ = 0, PC_CKV = 256, PC_KR = 384, PC_NQ = 416, PC_KC = 800, PC_VC = 928, PC_KS = 1056, PC_VS = 1184, PC_KW = 1312, PC_VW = 1440,
              PC_SBQ = 1568, PC_SBK = 1824, PC_SBV = 2080, PC_GATE = 2336;
constexpr size_t MiB = 1u << 20;
constexpr size_t WS_CTL = 0, WS_WGU = 1 * MiB, WS_WD = 12 * MiB, WS_WIN = 18 * MiB, WS_WOUT = 23 * MiB, WS_WC1 = 25 * MiB, WS_WUQ = 26 * MiB,
                 WS_WUKV = 26 * MiB + 512 * 1024, WS_WC2 = 26 * MiB + 768 * 1024, WS_HN = 28 * MiB, WS_R = 60 * MiB, WS_GATES = 140 * MiB,
                 WS_MASK = 142 * MiB, WS_LSE = 142 * MiB + 512 * 1024, WS_HID = 143 * MiB, WS_KCVC = 145 * MiB, WS_QMLA = 148 * MiB,
                 WS_KVB = 166 * MiB, WS_OCMP = 190 * MiB, WS_FLAT = 202 * MiB, WS_S1 = 202 * MiB, WS_S2 = 218 * MiB, WS_ROPE = 234 * MiB, WS_PART = 236 * MiB, WS_END = 252 * MiB;
constexpr size_t ROPE_MLA_COS = 0, ROPE_MLA_SIN = 8192 * 16, ROPE_NSA_COS = 2 * 8192 * 16, ROPE_NSA_SIN = 2 * 8192 * 16 + 8192 * 8;
constexpr int LDS_BYTES = 131072 + 1024;
constexpr int PTAB = 131072 + 64;

DI unsigned cvtpk(float lo, float hi) { f32x2 v = {lo, hi}; bf16x2_t b = __builtin_convertvector(v, bf16x2_t); return __builtin_bit_cast(unsigned, b); }
DI float bf2f(unsigned short h) { return __uint_as_float(((unsigned)h) << 16); }
DI float bflo(unsigned w) { return __uint_as_float(w << 16); }
DI float bfhi(unsigned w) { return __uint_as_float(w & 0xffff0000u); }
DI int fresh_tid() { int t = threadIdx.x; asm volatile("" : "+v"(t)); return t; }
DI int fresh_tid2(int wv) { unsigned z_ = 0u; asm volatile("" : "+v"(z_)); const int l_ = (int)__builtin_amdgcn_mbcnt_hi(~0u, __builtin_amdgcn_mbcnt_lo(~0u, z_)); return (wv << 6) | l_; }
DI LAS unsigned char* fresh_lds(LAS unsigned char* p) { asm volatile("" : "+s"(p)); return p; }
DI int fresh_s(int x) { asm volatile("" : "+s"(x)); return x; }
DI int perm32(int p) { return (p & 1) ? (p >> 1) + 16 : (p >> 1); }
DI int perm64(int p) { return p < 16 ? ((p & 1) ? (p >> 1) + 8 : (p >> 1)) : p; }
#define SWZ(v, x) __int_as_float(__builtin_amdgcn_ds_swizzle(__float_as_int(v), (((x) << 10) | 0x1f)))
DI float half_sum(float v) { auto rr = __builtin_amdgcn_permlane32_swap(__float_as_uint(v), __float_as_uint(v), false, false); return __uint_as_float(rr[0]) + __uint_as_float(rr[1]); }
DI float half_max(float v) { auto rr = __builtin_amdgcn_permlane32_swap(__float_as_uint(v), __float_as_uint(v), false, false); return fmaxf(__uint_as_float(rr[0]), __uint_as_float(rr[1])); }
DI float half_other(float v, int hi) { auto rr = __builtin_amdgcn_permlane32_swap(__float_as_uint(v), __float_as_uint(v), false, false); return __uint_as_float(hi ? rr[0] : rr[1]); }
DI float wave_sum(float v) {
    v += SWZ(v, 1); v += SWZ(v, 2); v += SWZ(v, 4); v += SWZ(v, 8); v += SWZ(v, 16);
    return half_sum(v);
}
DI void rope_cs(int pos, float inv_freq, float& c, float& s) {
    const float ang = (float)pos * inv_freq;
    double rev = (double)ang * 0.15915494309189535; rev -= __builtin_rint(rev);
    const float r = (float)rev; c = __builtin_amdgcn_cosf(r); s = __builtin_amdgcn_sinf(r);
}
DI float inv_freq_of(int i, float inv_half) { return exp2f(-(float)i * inv_half * 18.931568569324174f); }

namespace pg8 {
constexpr int BM = 256, BK = 64, HALF = 128, HTB = HALF * BK * 2, STAGE_BYTES = 8 * HTB, NXCD = 8, WGM = 4;
DI int lds_byte(int r, int c) { const int st = (r >> 4) * 2 + (c >> 5), rr = r & 15, cc = c & 31, ob = rr * 64 + cc * 2; return st * 1024 + (ob ^ (((ob >> 9) & 1) << 5)); }
DI void stage_rc(int b, int& R, int& C) { const int st = b / 1024, sb = b % 1024, swz = sb ^ (((sb >> 9) & 1) << 5); R = (st >> 1) * 16 + swz / 64; C = (st & 1) * 32 + (swz % 64) / 2; }
DI int perm32r(int rho) { const int n = rho >> 4, i = rho & 15; return 8 * (i >> 2) + 4 * n + (i & 3); }
struct Unit { int pm, pn; };
struct Gemm { const bf16_t* A; const bf16_t* Bt; int M, N, K, lda, ldb; };
struct StaticOrder {
    int nM, nN, nwg, G, c;
    DI void init(int M, int N, int G_, int c_) { nM = M / BM; nN = N / BM; nwg = nM * nN; G = G_; c = c_; }
    DI bool next(int i, Unit& u) const {
        const long L = (long)i * G + c; if (L >= nwg) return false;
        int wgid = (int)L; { const int q = nwg / NXCD, r = nwg % NXCD, xcd = wgid % NXCD, off = wgid / NXCD; wgid = (xcd < r ? xcd * (q + 1) : r * (q + 1) + (xcd - r) * q) + off; }
        const int nig = WGM * nN, gid = wgid / nig, fm = gid * WGM, gsz = (nM - fm) < WGM ? (nM - fm) : WGM;
        u.pm = fm + ((wgid % nig) % gsz); u.pn = (wgid % nig) / gsz; return true;
    }
};
typedef f32x4 Acc[2][2][4][2];

struct EpiSwiGLU {
    static constexpr bool PERM = true;
    bf16_t* O; int ldc;
    DI void operator()(const Acc& acc, const Unit& u, int wr, int wc, int fr, int fq) const {
        const int row0 = u.pm * BM + wr * 64 + fr, col0 = u.pn * HALF + wc * 32 + 8 * fq;
#pragma unroll
        for (int ai = 0; ai < 2; ++ai)
#pragma unroll
            for (int m = 0; m < 4; ++m) {
                bf16_t* rowp = O + (size_t)(row0 + ai * HALF + m * 16) * ldc + col0;
                float v[8];
#pragma unroll
                for (int n = 0; n < 2; ++n)
#pragma unroll
                    for (int i = 0; i < 4; ++i) { const float g = acc[ai][0][m][n][i], up = acc[ai][1][m][n][i]; v[n * 4 + i] = g * __builtin_amdgcn_rcpf(1.f + __expf(-g)) * up; }
                u32x4 w; w.x = cvtpk(v[0], v[1]); w.y = cvtpk(v[2], v[3]); w.z = cvtpk(v[4], v[5]); w.w = cvtpk(v[6], v[7]);
                *(u32x4*)rowp = w;
                asm volatile("" ::: "memory");
            }
    }
};
struct EpiResid {
    static constexpr bool PERM = false;
    const float* base; float* out; int ldc; float alpha;
    DI void operator()(const Acc& acc, const Unit& u, int wr, int wc, int fr, int fq) const {
        const int row0 = u.pm * BM + wr * 64 + fr, col0 = u.pn * BM + wc * 32 + 4 * fq;
#pragma unroll
        for (int ai = 0; ai < 2; ++ai)
#pragma unroll
            for (int m = 0; m < 4; ++m) {
                const size_t off = (size_t)(row0 + ai * HALF + m * 16) * ldc + col0;
#pragma unroll
                for (int bj = 0; bj < 2; ++bj)
#pragma unroll
                    for (int n = 0; n < 2; ++n) { const f32x4 b = *(const f32x4*)(base + off + bj * HALF + n * 16); *(f32x4*)(out + off + bj * HALF + n * 16) = b + acc[ai][bj][m][n] * alpha; }
                asm volatile("" ::: "memory");
            }
    }
};
struct EpiF32 {
    static constexpr bool PERM = false;
    float* O; int ldc;
    DI void operator()(const Acc& acc, const Unit& u, int wr, int wc, int fr, int fq) const {
        const int row0 = u.pm * BM + wr * 64 + fr, col0 = u.pn * BM + wc * 32 + 4 * fq;
#pragma unroll
        for (int ai = 0; ai < 2; ++ai)
#pragma unroll
            for (int m = 0; m < 4; ++m) {
                const size_t off = (size_t)(row0 + ai * HALF + m * 16) * ldc + col0;
#pragma unroll
                for (int bj = 0; bj < 2; ++bj)
#pragma unroll
                    for (int n = 0; n < 2; ++n) *(f32x4*)(O + off + bj * HALF + n * 16) = acc[ai][bj][m][n];
                asm volatile("" ::: "memory");
            }
    }
};
template <int ACT> struct EpiBf16 {
    static constexpr bool PERM = true;
    bf16_t* O; int ldc; int ncols;
    DI void operator()(const Acc& acc, const Unit& u, int wr, int wc, int fr, int fq) const {
        const int row0 = u.pm * BM + wr * 64 + fr, col0 = u.pn * BM + wc * 32 + 8 * fq;
#pragma unroll
        for (int ai = 0; ai < 2; ++ai)
#pragma unroll
            for (int m = 0; m < 4; ++m) {
                bf16_t* rowp = O + (size_t)(row0 + ai * HALF + m * 16) * ldc + col0;
#pragma unroll
                for (int bj = 0; bj < 2; ++bj) {
                    if (col0 + bj * HALF >= ncols) continue;
                    float v[8];
#pragma unroll
                    for (int n = 0; n < 2; ++n)
#pragma unroll
                        for (int i = 0; i < 4; ++i) { float x = acc[ai][bj][m][n][i];
                            if (ACT == 2) { const float y = 0.7978845608028654f * (x + 0.044715f * x * x * x); x = x * __builtin_amdgcn_rcpf(1.f + __expf(-2.f * y)); }
                            v[n * 4 + i] = x; }
                    u32x4 w; w.x = cvtpk(v[0], v[1]); w.y = cvtpk(v[2], v[3]); w.z = cvtpk(v[4], v[5]); w.w = cvtpk(v[6], v[7]);
                    *(u32x4*)(rowp + bj * HALF) = w;
                }
                asm volatile("" ::: "memory");
            }
    }
};
template <class Epi>
DI void gemm_phase(LAS unsigned char* lds, const Gemm g, const StaticOrder& S, const Epi& E, int wv0) {
    const int tid = fresh_tid2(wv0), wid = __builtin_amdgcn_readfirstlane(tid >> 6), lane = tid & 63, wr = wid >> 2, wc = wid & 3, fr = lane & 15, fq = lane >> 4;
    const int K = g.K, nt = K / BK;
    unsigned voffA[2], voffB[2];
#pragma unroll
    for (int i = 0; i < 2; ++i) { int R, C; stage_rc(tid * 16 + i * 8192, R, C); const int Rb = Epi::PERM ? ((R & ~31) + perm32r(R & 31)) : R;
        voffA[i] = (unsigned)(R * g.lda + C) * 2u; voffB[i] = (unsigned)(Rb * g.ldb + C) * 2u; }
    const size_t kstep = (size_t)(BK * 2);
    const size_t hstepA = (size_t)HALF * g.lda * 2, hstepB = (size_t)HALF * g.ldb * 2;
    const size_t tstepA = 2 * hstepA, tstepB = 2 * hstepB;
    const unsigned ldsw = (unsigned)wid * 1024u;
    const int aoff = lds_byte(wr * 64 + fr, fq * 8), boff = lds_byte(wc * 32 + fr, fq * 8);
#define PG8_SA(b, h) (((b) * 2 + (h)) * HTB)
#define PG8_SB(b, h) ((4 + (b) * 2 + (h)) * HTB)
#define PG8_STAGE(bufoff, gbase, voff) do { _Pragma("unroll") for (int _i = 0; _i < 2; ++_i) \
        __builtin_amdgcn_global_load_lds((const unsigned*)((const char*)(gbase) + (voff)[_i]), (LAS unsigned*)(lds + (bufoff) + ldsw + _i * 8192), 16, 0, 0); } while (0)
#define PG8_LDA(dst, b, h) do { _Pragma("unroll") for (int m = 0; m < 4; ++m) _Pragma("unroll") for (int k = 0; k < 2; ++k) dst[m][k] = *(const LAS bf16x8*)(lds + PG8_SA(b, h) + aoff + m * 2048 + k * 1024); } while (0)
#define PG8_LDB(dst, b, h) do { _Pragma("unroll") for (int n = 0; n < 2; ++n) _Pragma("unroll") for (int k = 0; k < 2; ++k) dst[n][k] = *(const LAS bf16x8*)(lds + PG8_SB(b, h) + boff + n * 2048 + k * 1024); } while (0)
#define PG8_MMA(ai, bj, At, Bt) do { __builtin_amdgcn_s_setprio(1); _Pragma("unroll") for (int m = 0; m < 4; ++m) _Pragma("unroll") for (int n = 0; n < 2; ++n) _Pragma("unroll") for (int k = 0; k < 2; ++k) \
        acc[ai][bj][m][n] = __builtin_amdgcn_mfma_f32_16x16x32_bf16(Bt[n][k], At[m][k], acc[ai][bj][m][n], 0, 0, 0); __builtin_amdgcn_s_setprio(0); } while (0)
#define PG8_WAIT_V(n) asm volatile("s_waitcnt vmcnt(" #n ")" ::: "memory")
#define PG8_WAIT_L(n) asm volatile("s_waitcnt lgkmcnt(" #n ")" ::: "memory")
#define PG8_BAR __builtin_amdgcn_s_barrier()
#define PG8_SCHED __builtin_amdgcn_sched_barrier(0)
    Unit cur, nxt; int ui = 0;
    if (!S.next(0, cur)) return;
    Acc acc;
#pragma unroll
    for (int a = 0; a < 2; ++a)
#pragma unroll
        for (int b = 0; b < 2; ++b)
#pragma unroll
            for (int m = 0; m < 4; ++m)
#pragma unroll
                for (int n = 0; n < 2; ++n) acc[a][b][m][n] = (f32x4){0.f, 0.f, 0.f, 0.f};
    bf16x8 At[4][2], B0[2][2], B1[2][2];
    const char* cA = (const char*)g.A + (size_t)cur.pm * tstepA; const char* cB = (const char*)g.Bt + (size_t)cur.pn * tstepB;
    PG8_STAGE(PG8_SB(0, 0), cB, voffB); PG8_STAGE(PG8_SB(0, 1), cB + hstepB, voffB); PG8_STAGE(PG8_SA(0, 0), cA, voffA); PG8_STAGE(PG8_SA(0, 1), cA + hstepA, voffA);
    if (wr == 1) PG8_BAR;
    PG8_WAIT_V(2); PG8_BAR;
    PG8_STAGE(PG8_SB(1, 0), cB + kstep, voffB); PG8_STAGE(PG8_SA(1, 0), cA + kstep, voffA); PG8_STAGE(PG8_SB(1, 1), cB + hstepB + kstep, voffB);
    PG8_WAIT_V(6); PG8_BAR;
    for (;;) {
        const bool has_next = S.next(ui + 1, nxt);
        const char* nA = has_next ? (const char*)g.A + (size_t)nxt.pm * tstepA : cA; const char* nB = has_next ? (const char*)g.Bt + (size_t)nxt.pn * tstepB : cB;
        for (int t = 0; t < nt; t += 2) {
            const bool last = (t == nt - 2);
            const char* a1 = cA + (size_t)(t + 1) * kstep;
            const char* a2 = last ? nA : cA + (size_t)(t + 2) * kstep; const char* b2 = last ? nB : cB + (size_t)(t + 2) * kstep;
            const char* a3 = a2 + kstep; const char* b3 = b2 + kstep;
            PG8_LDB(B0, 0, 0); PG8_LDB(B1, 0, 1); PG8_SCHED; PG8_LDA(At, 0, 0); PG8_STAGE(PG8_SA(1, 1), a1 + hstepA, voffA);
            PG8_WAIT_V(8); PG8_WAIT_L(0); PG8_BAR; PG8_MMA(0, 0, At, B0); PG8_MMA(0, 1, At, B1); PG8_BAR; PG8_SCHED;
            PG8_LDA(At, 0, 1); PG8_STAGE(PG8_SB(0, 0), b2, voffB); PG8_STAGE(PG8_SB(0, 1), b2 + hstepB, voffB); PG8_STAGE(PG8_SA(0, 0), a2, voffA);
            PG8_WAIT_V(8); PG8_WAIT_L(0); PG8_BAR; PG8_MMA(1, 0, At, B0); PG8_MMA(1, 1, At, B1); PG8_BAR; PG8_SCHED;
            PG8_LDB(B0, 1, 0); PG8_LDB(B1, 1, 1); PG8_SCHED; PG8_LDA(At, 1, 0); PG8_STAGE(PG8_SA(0, 1), a2 + hstepA, voffA);
            PG8_WAIT_V(8); PG8_WAIT_L(0); PG8_BAR; PG8_MMA(0, 0, At, B0); PG8_MMA(0, 1, At, B1); PG8_BAR; PG8_SCHED;
            PG8_LDA(At, 1, 1); PG8_STAGE(PG8_SB(1, 0), b3, voffB); PG8_STAGE(PG8_SB(1, 1), b3 + hstepB, voffB); PG8_STAGE(PG8_SA(1, 0), a3, voffA);
            PG8_WAIT_V(8); PG8_WAIT_L(0); PG8_BAR; PG8_MMA(1, 0, At, B0); PG8_MMA(1, 1, At, B1); PG8_BAR; PG8_SCHED;
        }
        if (wr == 0) PG8_BAR;
        { const int l2_ = fresh_tid2(wv0) & 63; E(acc, cur, wr, wc, l2_ & 15, l2_ >> 4); }
        if (!has_next) break;
#pragma unroll
        for (int a = 0; a < 2; ++a)
#pragma unroll
            for (int b = 0; b < 2; ++b)
#pragma unroll
                for (int m = 0; m < 4; ++m)
#pragma unroll
                    for (int n = 0; n < 2; ++n) acc[a][b][m][n] = (f32x4){0.f, 0.f, 0.f, 0.f};
        cur = nxt; cA = nA; cB = nB; ++ui;
        if (wr == 1) PG8_BAR;
    }
    PG8_WAIT_V(0);
    PG8_BAR;
#undef PG8_SA
#undef PG8_SB
#undef PG8_STAGE
#undef PG8_LDA
#undef PG8_LDB
#undef PG8_MMA
#undef PG8_WAIT_V
#undef PG8_WAIT_L
#undef PG8_BAR
#undef PG8_SCHED
}
}

struct FGU { const float* wg; const float* wu; DI float operator()(int n, int k) const { const int pn = n >> 8, j = n & 255; const long d = (j < 128) ? 0 : (wu - wg); return wg[(long)k * DFF + pn * 128 + (j & 127) + d]; } };
struct FPlain { const float* w; int N; DI float operator()(int n, int k) const { return w[(size_t)k * N + n]; } };
DI int win_src_col(int d) {
    if (d >= DIN) return -1;
    if (d >= PC_GATE) return 1568 + (d - PC_GATE);
    if (d >= PC_SBQ) return d + 18;
    if (d < PC_KR) return d;
    if (d < PC_NQ) return PC_KR + perm32(d - PC_KR);
    const int e = d - PC_NQ, hd = e >> 6, p = e & 63;
    const bool roped = hd < 8 || hd == 10 || hd == 11 || hd == 14 || hd == 15;
    return PC_NQ + hd * 64 + (roped ? perm64(p) : p);
}
struct FWin { const float* w; DI float operator()(int n, int k) const { const int c = win_src_col(n); return c < 0 ? 0.f : w[(size_t)k * DIN + c]; } };
struct FUq { const float* w; DI float operator()(int n, int k) const { if (n >= 576) return 0.f; const int h = n / 96, j = n % 96; const int c = h * 96 + (j < 64 ? j : 64 + perm32(j - 64)); return w[(size_t)k * 576 + c]; } };
struct FUkv { const float* w; DI float operator()(int n, int k) const { int c; if (n < 384) c = (n >> 6) * 128 + (n & 63); else c = ((n - 384) >> 6) * 128 + 64 + (n & 63); return w[(size_t)k * 768 + c]; } };
struct FC1 { const float* wk; const float* wv; DI float operator()(int n, int k) const { const int t = k >> 6, d = k & 63; const long off = (n < 128) ? (long)(t * 64 + perm64(d)) * 128 + n : (long)k * 128 + (n - 128) + (wv - wk); return wk[off]; } };
struct FC2 { const float* wk; const float* wv; DI float operator()(int n, int k) const {
    const bool isk = n < 64 && k < 128, isv = n >= 64 && n < 128 && k >= 128;
    const long off = isk ? (long)(k * 64 + perm64(n & 63)) : isv ? (long)((k - 128) * 64 + (n - 64)) + (wv - wk) : 0;
    const float v = wk[off]; return (isk || isv) ? v : 0.f; } };

template <class F>
DI void conv_matrix(const F& f, int K, int Nd, bf16_t* dst, LAS float* scr, int gw, int NGW, int lane) {
    const int nblk = Nd / 32, items = (K / 64) * nblk;
    for (int it = gw; it < items; it += NGW) {
        const int kb = it / nblk, nb = it % nblk, k0 = 64 * kb, n0 = 32 * nb;
float tmp_[32];
#pragma unroll
        for (int i = 0; i < 32; ++i) tmp_[i] = f(n0 + (lane & 31), k0 + 2 * i + (lane >> 5));
#pragma unroll
        for (int i = 0; i < 32; ++i) scr[(2 * i + (lane >> 5)) * 33 + (lane & 31)] = tmp_[i];
        asm volatile("s_waitcnt lgkmcnt(0)" ::: "memory");
        const int c = lane & 7;
#pragma unroll
        for (int j = 0; j < 4; ++j) { const int n = (lane >> 3) + 8 * j; const LAS float* s = scr + (8 * c) * 33 + n;
            u32x4 o; o.x = cvtpk(s[0 * 33], s[1 * 33]); o.y = cvtpk(s[2 * 33], s[3 * 33]); o.z = cvtpk(s[4 * 33], s[5 * 33]); o.w = cvtpk(s[6 * 33], s[7 * 33]);
            *(u32x4*)(dst + (size_t)(n0 + n) * K + k0 + 8 * c) = o; }
        asm volatile("s_waitcnt lgkmcnt(0)" ::: "memory");
    }
}

DI int crow(int r, int hi) { return (r & 3) + 8 * (r >> 2) + 4 * hi; }
#define MFMA32(a, b, c) __builtin_amdgcn_mfma_f32_32x32x16_bf16((a), (b), (c), 0, 0, 0)
DI bf16x8 pack8(const f32x16& x, int s) {
    u32x4 p; p.x = cvtpk(x[8 * s], x[8 * s + 1]); p.y = cvtpk(x[8 * s + 2], x[8 * s + 3]); p.z = cvtpk(x[8 * s + 4], x[8 * s + 5]); p.w = cvtpk(x[8 * s + 6], x[8 * s + 7]);
    return __builtin_bit_cast(bf16x8, p);
}
typedef short v4i16_t __attribute__((ext_vector_type(4)));
DI s16x4 vtr(const LAS unsigned char* p) { return __builtin_bit_cast(s16x4, __builtin_amdgcn_ds_read_tr16_b64_v4i16((LAS v4i16_t*)p)); }
constexpr int VP2 = 144;
constexpr int AT_K = 0, AT_V = 28672, AT_MISC = 49152;
DI bf16x8 vfrag(const LAS unsigned char* Vs, int lane, int d0, int kb, int s) {
    const int i16 = lane & 15, g = lane >> 4, blk = g & 1, hi = g >> 1;
    const LAS unsigned char* p = Vs + (32 * kb + 16 * s + 4 * hi + (i16 >> 2)) * VP2 + 64 * d0 + 32 * blk + 8 * (i16 & 3);
    const s16x4 lo = vtr(p), hh = vtr(p + 8 * VP2);
    return (bf16x8){lo[0], lo[1], lo[2], lo[3], hh[0], hh[1], hh[2], hh[3]};
}
DI void store_o(const f32x16 (&o)[2], bf16_t* dst_row, int hi) {
#pragma unroll
    for (int d0 = 0; d0 < 2; ++d0)
#pragma unroll
        for (int jp = 0; jp < 4; jp += 2) {
            const unsigned a0 = cvtpk(o[d0][4 * jp], o[d0][4 * jp + 1]), a1 = cvtpk(o[d0][4 * jp + 2], o[d0][4 * jp + 3]);
            const unsigned b0 = cvtpk(o[d0][4 * jp + 4], o[d0][4 * jp + 5]), b1 = cvtpk(o[d0][4 * jp + 6], o[d0][4 * jp + 7]);
            const auto r0 = __builtin_amdgcn_permlane32_swap(a0, b0, false, false);
            const auto r1 = __builtin_amdgcn_permlane32_swap(a1, b1, false, false);
            const u32x4 w = {r0[0], r1[0], r0[1], r1[1]};
            *(u32x4*)(dst_row + 32 * d0 + 8 * (jp + hi)) = w;
        }
}

enum { MODE_CAUSAL = 0, MODE_CMP = 1, MODE_SEL = 2, MODE_WIN = 3 };
template <int DQK, int MODE>
DI void flash_unit(LAS unsigned char* lds, int wv0, const bf16_t* Qp, int qpitch, const bf16_t* K1, int k1pitch, const bf16_t* K2, int k2pitch,
                   const bf16_t* Vp, int vpitch, int q0, int t0, int t1, float sc, u32x4 mw, float gate, f32x16 (&tot)[2], float* lse_out, const float* rope = nullptr) {
    constexpr int KP2 = (DQK + 8) * 2, NKS = DQK / 16, KBUF = 64 * KP2, VBUF = 64 * VP2;
    const int tid = fresh_tid2(wv0), lane = tid & 63, wid = wv0, r32 = lane & 31, hi = lane >> 5;
    const int qpos = q0 + 32 * wid + r32, qmin = q0 + 32 * wid, qmax = qmin + 31;
    bf16x8 qf[NKS];
#pragma unroll
    for (int ks = 0; ks < NKS; ++ks) qf[ks] = *(const bf16x8*)(Qp + (size_t)(32 * wid + r32) * qpitch + 16 * ks + 8 * hi);
    if (DQK == 96) {
#pragma unroll
        for (int ks = 4; ks < NKS; ++ks) {
            const int p0 = 8 * (ks - 4) + 4 * hi;
            const f32x4 c4 = *(const f32x4*)(rope + ROPE_MLA_COS + qpos * 16 + p0), s4 = *(const f32x4*)(rope + ROPE_MLA_SIN + qpos * 16 + p0);
            u32x4 w = __builtin_bit_cast(u32x4, qf[ks]);
#pragma unroll
            for (int k = 0; k < 4; ++k) { const float x1 = bflo(w[k]), x2 = bfhi(w[k]); w[k] = cvtpk(x1 * c4[k] - x2 * s4[k], x2 * c4[k] + x1 * s4[k]); }
            qf[ks] = __builtin_bit_cast(bf16x8, w);
        }
    }
#pragma unroll
    for (int ks = 0; ks < NKS; ++ks) asm volatile("" : "+v"(qf[ks]));
    f32x16 o[2]; o[0] = (f32x16){}; o[1] = (f32x16){};
    float mref = -1e30f, l = 0.f;
    const int srow = tid >> 3, sch = tid & 7, srow2 = tid >> 2, sch2 = tid & 3;
    u32x4 rk1, rk2 = (u32x4){}, rv;
#define FL_GLOAD(t) do { const size_t kv_ = (size_t)64 * (t); rk1 = *(const u32x4*)(K1 + (kv_ + srow) * k1pitch + sch * 8); \
        if (DQK == 96 && tid < 256) rk2 = *(const u32x4*)(K2 + (kv_ + srow2) * k2pitch + sch2 * 8); \
        rv = *(const u32x4*)(Vp + (kv_ + srow) * vpitch + sch * 8); } while (0)
#define FL_LSTORE(buf) do { *(LAS u32x4*)(lds + AT_K + (buf) * KBUF + srow * KP2 + sch * 16) = rk1; \
        if (DQK == 96 && tid < 256) *(LAS u32x4*)(lds + AT_K + (buf) * KBUF + srow2 * KP2 + 128 + sch2 * 16) = rk2; \
        *(LAS u32x4*)(lds + AT_V + (buf) * VBUF + srow * VP2 + sch * 16) = rv; } while (0)
    FL_GLOAD(t0);
    __syncthreads();
    FL_LSTORE(0);
    if (t0 + 1 < t1) FL_GLOAD(t0 + 1);
    __syncthreads();
    for (int t = t0; t < t1; ++t) {
        const int cur = (t - t0) & 1;
        const LAS unsigned char* Ks = lds + AT_K + cur * KBUF; const LAS unsigned char* Vs = lds + AT_V + cur * VBUF;
        bool active = true;
        if (MODE == MODE_CAUSAL || MODE == MODE_SEL || MODE == MODE_WIN) active = (64 * t <= qmax);
        if (MODE == MODE_WIN) active = active && (64 * t + 63 + 512 > qmin);
        if (MODE == MODE_CMP) active = (16 * (64 * t) + 31 <= qmax);
        if (active) {
            f32x16 s[2];
            bf16x8 ka[2][NKS]; s16x4 vlo[2][2][2], vhi[2][2][2];
            {
                const unsigned kaddr = (unsigned)(unsigned long)(lds + AT_K + cur * KBUF) + (unsigned)(r32 * KP2 + hi * 16);
                const unsigned vaddr = (unsigned)(unsigned long)(lds + AT_V + cur * VBUF) + (unsigned)((4 * hi + ((lane & 15) >> 2)) * VP2 + 32 * ((lane >> 4) & 1) + 8 * (lane & 3));
#pragma unroll
                for (int kb = 0; kb < 2; ++kb)
#pragma unroll
                    for (int ks = 0; ks < NKS; ++ks) asm volatile("ds_read_b128 %0, %1 offset:%2" : "=v"(ka[kb][ks]) : "v"(kaddr), "n"(kb * 32 * KP2 + ks * 32) : "memory");
#pragma unroll
                for (int s2 = 0; s2 < 2; ++s2)
#pragma unroll
                    for (int d0 = 0; d0 < 2; ++d0) {
                        asm volatile("ds_read_b64_tr_b16 %0, %1 offset:%2" : "=v"(vlo[0][s2][d0]) : "v"(vaddr), "n"(16 * s2 * VP2 + 64 * d0) : "memory");
                        asm volatile("ds_read_b64_tr_b16 %0, %1 offset:%2" : "=v"(vhi[0][s2][d0]) : "v"(vaddr), "n"(16 * s2 * VP2 + 64 * d0 + 8 * VP2) : "memory");
                    }
                asm volatile("s_waitcnt lgkmcnt(8)" ::: "memory");
#pragma unroll
                for (int kb = 0; kb < 2; ++kb)
#pragma unroll
                    for (int ks = 0; ks < NKS; ++ks) asm volatile("" : "+v"(ka[kb][ks]));
                s[0] = (f32x16){}; s[1] = (f32x16){};
                __builtin_amdgcn_s_setprio(1);
#pragma unroll
                for (int ks = 0; ks < NKS; ++ks) { s[0] = MFMA32(ka[0][ks], qf[ks], s[0]); s[1] = MFMA32(ka[1][ks], qf[ks], s[1]); }
                __builtin_amdgcn_s_setprio(0);
#pragma unroll
                for (int s2 = 0; s2 < 2; ++s2)
#pragma unroll
                    for (int d0 = 0; d0 < 2; ++d0) {
                        asm volatile("ds_read_b64_tr_b16 %0, %1 offset:%2" : "=v"(vlo[1][s2][d0]) : "v"(vaddr), "n"((32 + 16 * s2) * VP2 + 64 * d0) : "memory");
                        asm volatile("ds_read_b64_tr_b16 %0, %1 offset:%2" : "=v"(vhi[1][s2][d0]) : "v"(vaddr), "n"((32 + 16 * s2) * VP2 + 64 * d0 + 8 * VP2) : "memory");
                    }
            }
            bool need_mask;
            if (MODE == MODE_CMP) need_mask = true;
            else if (MODE == MODE_WIN) need_mask = (64 * t + 63 > qmin) || (64 * t + 512 <= qmax);
            else need_mask = (64 * t + 63 > qmin);
            if (need_mask) {
#pragma unroll
                for (int kb = 0; kb < 2; ++kb)
#pragma unroll
                    for (int i = 0; i < 16; ++i) {
                        const int kv = 64 * t + 32 * kb + crow(i, hi);
                        bool valid;
                        if (MODE == MODE_CMP) valid = (16 * kv + 31 <= qpos);
                        else if (MODE == MODE_WIN) valid = (kv <= qpos) && (kv + 512 > qpos);
                        else valid = kv <= qpos;
                        s[kb][i] = valid ? s[kb][i] : -INFINITY;
                    }
            }
            if (MODE == MODE_SEL) {
                const unsigned w = (t < 32) ? mw.x : (t < 64) ? mw.y : (t < 96) ? mw.z : mw.w; const bool selw = ((w >> (t & 31)) & 1u) != 0;
                if (!__all(selw)) {
#pragma unroll
                    for (int kb = 0; kb < 2; ++kb)
#pragma unroll
                        for (int i = 0; i < 16; ++i) s[kb][i] = selw ? s[kb][i] : -INFINITY;
                }
            }
            float mx = fmaxf(s[0][0], s[1][0]);
#pragma unroll
            for (int i = 1; i < 16; ++i) mx = fmaxf(fmaxf(mx, s[0][i]), s[1][i]);
            mx = half_max(mx);
            const float msc = mx * sc;
            if (__any(msc > mref + 8.f)) {
                const float mnew = fmaxf(mref, msc), alpha = __builtin_amdgcn_exp2f(mref - mnew);
                mref = mnew; l *= alpha;
#pragma unroll
                for (int i = 0; i < 16; ++i) { o[0][i] *= alpha; o[1][i] *= alpha; }
            }
            float ls = 0.f;
#pragma unroll
            for (int kb = 0; kb < 2; ++kb)
#pragma unroll
                for (int i = 0; i < 16; ++i) { const float p = __builtin_amdgcn_exp2f(__builtin_fmaf(s[kb][i], sc, -mref)); s[kb][i] = p; ls += p; }
            l += ls;
            {
                asm volatile("s_waitcnt lgkmcnt(0)" ::: "memory");
#pragma unroll
                for (int kb = 0; kb < 2; ++kb)
#pragma unroll
                    for (int s2 = 0; s2 < 2; ++s2)
#pragma unroll
                        for (int d0 = 0; d0 < 2; ++d0) { asm volatile("" : "+v"(vlo[kb][s2][d0]), "+v"(vhi[kb][s2][d0])); }
                __builtin_amdgcn_s_setprio(1);
#pragma unroll
                for (int kb = 0; kb < 2; ++kb)
#pragma unroll
                    for (int s2 = 0; s2 < 2; ++s2) {
                        const bf16x8 pf = pack8(s[kb], s2);
#pragma unroll
                        for (int d0 = 0; d0 < 2; ++d0) {
                            const s16x4 lo = vlo[kb][s2][d0], hh = vhi[kb][s2][d0];
                            const bf16x8 vfr = (bf16x8){lo[0], lo[1], lo[2], lo[3], hh[0], hh[1], hh[2], hh[3]};
                            o[d0] = MFMA32(vfr, pf, o[d0]);
                        }
                    }
                __builtin_amdgcn_s_setprio(0);
            }
        }
        if (t + 1 < t1) { FL_LSTORE(cur ^ 1); if (t + 2 < t1) FL_GLOAD(t + 2); }
        __syncthreads();
    }
#undef FL_GLOAD
#undef FL_LSTORE
    const float lt = half_sum(l);
    bool rowok = true;
    if (MODE == MODE_CMP) rowok = qpos >= 31;
    const float inv = (rowok && lt > 0.f) ? gate / lt : 0.f;
#pragma unroll
    for (int i = 0; i < 16; ++i) { tot[0][i] += o[0][i] * inv; tot[1][i] += o[1][i] * inv; }
    if (MODE == MODE_CMP && hi == 0) lse_out[32 * wid + r32] = rowok ? (mref + log2f(lt)) : INFINITY;
}

DI void sb_unit(LAS unsigned char* lds, int wv0, const bf16_t* Qp, const bf16_t* Kp, const bf16_t* Vp, int q0, f32x16 (&o)[2]) {
    constexpr int KP2 = 144, pitch = NPROJ;
    const int tid = fresh_tid2(wv0), lane = tid & 63, wid = wv0, r32 = lane & 31, hi = lane >> 5;
    const int qpos = q0 + 32 * wid + r32, qmax = q0 + 32 * wid + 31;
    LAS unsigned char* Ks = lds + AT_K; LAS unsigned char* Vs = lds + AT_V; volatile LAS int* flags = (volatile LAS int*)(lds + AT_MISC);
    bf16x8 qf[4];
#pragma unroll
    for (int ks = 0; ks < 4; ++ks) qf[ks] = *(const bf16x8*)(Qp + (size_t)(32 * wid + r32) * pitch + 16 * ks + 8 * hi);
#pragma unroll
    for (int ks = 0; ks < 4; ++ks) asm volatile("" : "+v"(qf[ks]));
    float R = 0.f; bool wdone = false;
    const int srow = tid >> 3, sch = tid & 7;
    u32x4 rk, rv;
    const int tlast = (q0 + 255) >> 6;
    auto gload = [&](int t) { const size_t kv = (size_t)64 * t; rk = *(const u32x4*)(Kp + (kv + srow) * pitch + sch * 8); rv = *(const u32x4*)(Vp + (kv + srow) * pitch + sch * 8); };
    gload(tlast);
    if (lane == 0) flags[wid] = 0;
    for (int t = tlast; t >= 0; --t) {
        __syncthreads();
        { int alld = 1;
#pragma unroll
          for (int w = 0; w < 8; ++w) alld &= flags[w];
          if (alld) break; }
        *(LAS u32x4*)(Ks + srow * KP2 + sch * 16) = rk;
        *(LAS u32x4*)(Vs + srow * VP2 + sch * 16) = rv;
        __syncthreads();
        if (t > 0) gload(t - 1);
        const bool active = (64 * t < qmax) && !wdone;
        if (!active) continue;
        f32x16 s[2];
#pragma unroll
        for (int kb = 0; kb < 2; ++kb) {
            s[kb] = (f32x16){};
#pragma unroll
            for (int ks = 0; ks < 4; ++ks) { const bf16x8 a = *(const LAS bf16x8*)(Ks + (32 * kb + r32) * KP2 + ks * 32 + hi * 16); s[kb] = MFMA32(a, qf[ks], s[kb]); }
        }
        f32x16 lr[2];
        float own[8];
#pragma unroll
        for (int kb = 0; kb < 2; ++kb)
#pragma unroll
            for (int i = 0; i < 16; ++i) {
                const int kv = 64 * t + 32 * kb + crow(i, hi);
                const float z = s[kb][i] * 0.125f;
                const float sp = fmaxf(z, 0.f) + __logf(1.f + __expf(-fabsf(z)));
                const bool strict = kv < qpos;
                lr[kb][i] = strict ? -sp : 0.f;
                s[kb][i] = strict ? (z - sp) : -1e30f;
            }
#pragma unroll
        for (int g = 0; g < 8; ++g) { const int kb = g >> 2, j = g & 3; own[g] = (lr[kb][4 * j] + lr[kb][4 * j + 1]) + (lr[kb][4 * j + 2] + lr[kb][4 * j + 3]); }
        float E[8], Od[8], T[8];
#pragma unroll
        for (int g = 0; g < 8; ++g) { const float oth = half_other(own[g], hi); E[g] = hi ? oth : own[g]; Od[g] = hi ? own[g] : oth; }
        T[7] = 0.f;
#pragma unroll
        for (int g = 6; g >= 0; --g) T[g] = T[g + 1] + (E[g + 1] + Od[g + 1]);
        const float tile_tot = T[0] + (E[0] + Od[0]);
#pragma unroll
        for (int g = 0; g < 8; ++g) {
            const int kb = g >> 2, j = g & 3;
            const float sg = (hi ? T[g] : T[g] + Od[g]) + R;
            const float l3 = lr[kb][4 * j + 3], l2 = lr[kb][4 * j + 2], l1 = lr[kb][4 * j + 1];
            const float su3 = sg, su2 = sg + l3, su1 = su2 + l2, su0 = su1 + l1;
            s[kb][4 * j + 3] = exp2f((s[kb][4 * j + 3] + su3) * LOG2E);
            s[kb][4 * j + 2] = exp2f((s[kb][4 * j + 2] + su2) * LOG2E);
            s[kb][4 * j + 1] = exp2f((s[kb][4 * j + 1] + su1) * LOG2E);
            s[kb][4 * j + 0] = exp2f((s[kb][4 * j + 0] + su0) * LOG2E);
        }
        R += tile_tot;
#pragma unroll
        for (int kb = 0; kb < 2; ++kb)
#pragma unroll
            for (int s2 = 0; s2 < 2; ++s2) {
                const bf16x8 pf = pack8(s[kb], s2);
#pragma unroll
                for (int d0 = 0; d0 < 2; ++d0) { const bf16x8 vf = vfrag(Vs, lane, d0, kb, s2); o[d0] = MFMA32(vf, pf, o[d0]); }
            }
        if (!__any(R >= -104.f)) { wdone = true; if (lane == 0) flags[wid] = 1; }
    }
    if (lane == 0) flags[wid] = 1;
}


#define XB_TMO      128
#define XB_XCNT(j)  (256  + 64 * (j))
#define XB_XSUB(j)  (1280 + 64 * (j))
#define XB_XGEN(j)  (2304 + 64 * (j))
#define XB_TOP      3328
#define XB_TOPGEN   3392
#define XCD_BAR_WORDS 3456
#define XB_SPIN_CAP (1u << 18)
DI unsigned xb_ld(unsigned* p)              { return __hip_atomic_load(p, __ATOMIC_RELAXED, __HIP_MEMORY_SCOPE_AGENT); }
DI unsigned xb_add(unsigned* p, unsigned v) { return __hip_atomic_fetch_add(p, v, __ATOMIC_RELAXED, __HIP_MEMORY_SCOPE_AGENT); }
DI unsigned xb_xcc_id() { return (unsigned)__builtin_amdgcn_s_getreg((3 << 11) | 20) & 0xFu; }
#define XB_SPIN(cond, bar) do { unsigned _sp = 0; while (cond) { __builtin_amdgcn_s_sleep(1); \
    if ((++_sp & 255u) == 0u) { if (xb_ld(&(bar)[XB_TMO])) break; if (_sp > XB_SPIN_CAP) { atomicAdd(&(bar)[XB_TMO], 1u); break; } } } } while (0)
struct XcdBarrier { unsigned* bar; unsigned x; volatile LAS unsigned* st; };
DI void xcd_barrier_complete(unsigned* bar, unsigned x, unsigned& nloc, unsigned& nx) {
    const unsigned G = gridDim.x * gridDim.y * gridDim.z;
    unsigned sum, cnt, mine, sp = 0u;
    for (;;) {
        sum = 0u; cnt = 0u; mine = 0u;
#pragma unroll
        for (unsigned j = 0; j < 16; ++j) { const unsigned c = xb_ld(&bar[XB_XCNT(j)]); sum += c; cnt += (c > 0u) ? 1u : 0u; mine = (j == x) ? c : mine; }
        if (sum == G) break;
        __builtin_amdgcn_s_sleep(1);
        if ((++sp & 255u) == 0u) { if (xb_ld(&bar[XB_TMO])) break; if (sp > XB_SPIN_CAP) { atomicAdd(&bar[XB_TMO], 1u); break; } }
    }
    nloc = mine > 0u ? mine : 1u; nx = cnt > 0u ? cnt : 1u;
}
DI void xcd_barrier(const XcdBarrier& b) {
    asm volatile("s_waitcnt vmcnt(0)" ::: "memory");
    __syncthreads();
    if (threadIdx.x == 0) {
        unsigned* bar = b.bar;
        __builtin_amdgcn_s_waitcnt(0);
        unsigned nloc = b.st[0], nx = b.st[1];
        if (nloc == 0u) { xcd_barrier_complete(bar, b.x, nloc, nx); b.st[0] = nloc; b.st[1] = nx; }
        const unsigned old = xb_add(&bar[XB_XSUB(b.x)], 1u);
        const unsigned gen = old / nloc;
        if (old + 1u == (gen + 1u) * nloc) {
            __builtin_amdgcn_fence(__ATOMIC_RELEASE, "agent");
            asm volatile("s_waitcnt vmcnt(0)" ::: "memory");
            const unsigned og = xb_add(&bar[XB_TOP], 1u);
            const unsigned tg = og / nx;
            if (og + 1u == (tg + 1u) * nx) xb_add(&bar[XB_TOPGEN], 1u);
            else XB_SPIN(xb_ld(&bar[XB_TOPGEN]) == tg, bar);
            __builtin_amdgcn_fence(__ATOMIC_ACQUIRE, "agent");
            xb_add(&bar[XB_XGEN(b.x)], 1u);
            asm volatile("s_waitcnt vmcnt(0)" ::: "memory");
        } else {
            XB_SPIN(xb_ld(&bar[XB_XGEN(b.x)]) == gen, bar);
            __builtin_amdgcn_fence(__ATOMIC_ACQUIRE, "agent");
            asm volatile("s_waitcnt vmcnt(0)" ::: "memory");
        }
    }
    __syncthreads();
}
constexpr int BAR_WORD0 = 4096;
constexpr int LDS_BARST = 131072 + 32;

DI const float* gptr(LAS unsigned char* lds, int i);
DI void gsync(LAS unsigned char* lds) {
    XcdBarrier b; b.bar = (unsigned*)gptr(lds, 25) + BAR_WORD0; b.x = xb_xcc_id(); b.st = (volatile LAS unsigned*)(lds + LDS_BARST);
    xcd_barrier(b);
}
DI void gsync_cg(cg::grid_group& grid) {
    asm volatile("s_waitcnt vmcnt(0) lgkmcnt(0)" ::: "memory");
    grid.sync();
    __builtin_amdgcn_fence(__ATOMIC_ACQUIRE, "agent");
    asm volatile("s_waitcnt vmcnt(0)" ::: "memory");
}
DI void norm_rows(const float* src, const float* gain, bf16_t* HN, int gw, int NGW, int lane) {
    for (int mrow_ = gw; mrow_ < MTOK * REP_NORM; mrow_ += NGW) {
        const int mrow = mrow_ & (MTOK - 1);
        const f32x4* xr = (const f32x4*)(src + (size_t)mrow * DM) + lane;
        f32x4 v[4]; float ss = 0.f;
#pragma unroll
        for (int j = 0; j < 4; ++j) { v[j] = xr[64 * j]; ss += (v[j].x * v[j].x + v[j].y * v[j].y) + (v[j].z * v[j].z + v[j].w * v[j].w); }
        const float r = rsqrtf(wave_sum(ss) * (1.f / DM) + EPS);
        u32x2* o8 = (u32x2*)(HN + (size_t)mrow * DM) + lane;
#pragma unroll
        for (int j = 0; j < 4; ++j) { const f32x4 gg = ((const f32x4*)gain)[lane + 64 * j]; u32x2 w; w.x = cvtpk(v[j].x * r * gg.x, v[j].y * r * gg.y); w.y = cvtpk(v[j].z * r * gg.z, v[j].w * r * gg.w); o8[64 * j] = w; }
    }
}
DI void conv_ffn(const float* wg, const float* wu, const float* wd, bf16_t* Wgu, bf16_t* Wd, LAS float* scr, int gw, int NGW, int lane) {
    conv_matrix(FGU{wg, wu}, DM, 2 * DFF, Wgu, scr, gw, NGW, lane);
    conv_matrix(FPlain{wd, DM}, DFF, DM, Wd, scr, gw, NGW, lane);
}
DI void ffn_gemms(LAS unsigned char* lds, cg::grid_group& grid, unsigned char* ws, const float* base, float* X, int G, int bid, int wv0) {
    bf16_t* Wgu = (bf16_t*)(ws + WS_WGU); bf16_t* Wd = (bf16_t*)(ws + WS_WD); bf16_t* HN = (bf16_t*)(ws + WS_HN); bf16_t* ACT = (bf16_t*)(ws + WS_R);
    for (int rep = 0; rep < REP_FFN; ++rep) {
    { pg8::Gemm g{HN, Wgu, MTOK, 2 * DFF, DM, DM, DM}; pg8::StaticOrder S; S.init(MTOK, 2 * DFF, G, bid); pg8::EpiSwiGLU E{ACT, DFF}; pg8::gemm_phase(lds, g, S, E, wv0); }
    gsync(lds);
    { pg8::Gemm g{ACT, Wd, MTOK, DM, DFF, DFF, DFF}; pg8::StaticOrder S; S.init(MTOK, DM, G, bid); pg8::EpiResid E{rep == 0 ? base : X, X, DM, rep == 0 ? 0.5f : 0.f}; pg8::gemm_phase(lds, g, S, E, wv0); }
    gsync(lds);
    }
}

struct Params {
    const float* in[24];
    float* out;
    unsigned char* ws;
};

DI const float* gptr(LAS unsigned char* lds, int i) {
    LAS unsigned char* b = lds + PTAB; asm volatile("" : "+v"(b));
    volatile LAS unsigned* p = (volatile LAS unsigned*)(b + 8 * i);
    const unsigned lo = __builtin_amdgcn_readfirstlane(p[0]), hi = __builtin_amdgcn_readfirstlane(p[1]);
    return (const float*)(((unsigned long long)hi << 32) | lo);
}
#define PIN(i) gptr(lds, (i))
#define GET_WS() ((unsigned char*)gptr(lds, 25))
#define GET_X() ((float*)gptr(lds, 24))
#define WSP(type, off) ((type*)(ws + (off)))
#define Wgu WSP(bf16_t, WS_WGU)
#define Wd WSP(bf16_t, WS_WD)
#define Win WSP(bf16_t, WS_WIN)
#define Wout WSP(bf16_t, WS_WOUT)
#define Wc1 WSP(bf16_t, WS_WC1)
#define Wuq WSP(bf16_t, WS_WUQ)
#define Wukv WSP(bf16_t, WS_WUKV)
#define Wc2 WSP(bf16_t, WS_WC2)
#define HN WSP(bf16_t, WS_HN)
#define ACT WSP(bf16_t, WS_R)
#define PROJ WSP(bf16_t, WS_R)
#define GATES WSP(float, WS_GATES)
#define MASKS WSP(unsigned, WS_MASK)
#define LSE WSP(float, WS_LSE)
#define HID WSP(bf16_t, WS_HID)
#define KCVC WSP(bf16_t, WS_KCVC)
#define QMLA WSP(bf16_t, WS_QMLA)
#define KVB WSP(bf16_t, WS_KVB)
#define OCMP WSP(bf16_t, WS_OCMP)
#define FLAT WSP(bf16_t, WS_FLAT)
#define S1 WSP(float, WS_S1)
#define S2 WSP(float, WS_S2)
#define PHASE_PTRS unsigned char* ws = GET_WS(); float* X = GET_X(); (void)ws; (void)X; const int G = fresh_s(G0), bid = fresh_s(bid0), NGW = G * 8; (void)NGW; const int tid = fresh_tid2(wv0), lane = tid & 63, wid = wv0, gw = bid * 8 + wid; (void)lane; (void)gw; \
    LAS float* scr = (LAS float*)(lds + wid * 8704); (void)scr; volatile LAS int* s_item = (volatile LAS int*)(lds + 131072); (void)s_item

__global__ void __launch_bounds__(512) mega_fwd(Params P) {
    extern __shared__ __attribute__((aligned(16))) unsigned char lds_raw[];
    LAS unsigned char* const lds0 = (LAS unsigned char*)lds_raw;
#define lds fresh_lds(lds0)
    cg::grid_group grid = cg::this_grid();
    { const int tid = threadIdx.x;
    if (tid < 24) *(LAS unsigned long long*)(lds + PTAB + 8 * tid) = (unsigned long long)P.in[tid];
    if (tid == 24) *(LAS unsigned long long*)(lds + PTAB + 8 * 24) = (unsigned long long)P.out;
    if (tid == 25) *(LAS unsigned long long*)(lds + PTAB + 8 * 25) = (unsigned long long)P.ws;
    if (tid == 26) { *(LAS unsigned*)(lds + LDS_BARST) = 0u; *(LAS unsigned*)(lds + LDS_BARST + 4) = 0u; }
    if (tid == 0) (void)xb_add((unsigned*)P.ws + BAR_WORD0 + XB_XCNT(xb_xcc_id()), 1u); }
    __syncthreads();
    gsync_cg(grid);
    const int G0 = gridDim.x, bid0 = blockIdx.x;
    int wv0 = __builtin_amdgcn_readfirstlane((int)threadIdx.x >> 6); asm volatile("" : "+s"(wv0));

    for (int L = 0; L < 2; ++L) {
        { PHASE_PTRS; const float* xin = (L == 0) ? PIN(0) : X;
        norm_rows(xin, PIN(1) + L * DM, HN, gw, NGW, lane);
        if (L == 0) {
            float* rt = WSP(float, WS_ROPE);
            for (int idx = gw * 64 + lane; idx < 8192 * 16; idx += NGW * 64) { const int pos = idx >> 4, i = idx & 15; float c, sn; rope_cs(pos, inv_freq_of(i, 1.f / 16.f), c, sn); rt[ROPE_MLA_COS + idx] = c; rt[ROPE_MLA_SIN + idx] = sn; }
            for (int idx = gw * 64 + lane; idx < 8192 * 8; idx += NGW * 64) { const int pos = idx >> 3, i = idx & 7; float c, sn; rope_cs(pos, inv_freq_of(i, 1.f / 8.f), c, sn); rt[ROPE_NSA_COS + idx] = c; rt[ROPE_NSA_SIN + idx] = sn; }
        }
        for (int rep = 0; rep < REP_CONV; ++rep) {
        conv_ffn(PIN(2) + (size_t)L * DM * DFF, PIN(3) + (size_t)L * DM * DFF, PIN(4) + (size_t)L * DFF * DM, Wgu, Wd, scr, gw, NGW, lane);
        conv_matrix(FWin{PIN(6) + (size_t)L * DM * DIN}, DM, NPROJ, Win, scr, gw, NGW, lane);
        conv_matrix(FPlain{PIN(18) + (size_t)L * DM * DM, DM}, DM, DM, Wout, scr, gw, NGW, lane);
        conv_matrix(FUq{PIN(8) + (size_t)L * 256 * 576}, 256, 768, Wuq, scr, gw, NGW, lane);
        conv_matrix(FUkv{PIN(10) + (size_t)L * 128 * 768}, 128, 768, Wukv, scr, gw, NGW, lane);
        conv_matrix(FC1{PIN(13) + (size_t)L * 2048 * 128, PIN(16) + (size_t)L * 2048 * 128}, 2048, 256, Wc1, scr, gw, NGW, lane);
        conv_matrix(FC2{PIN(14) + (size_t)L * 128 * 64, PIN(17) + (size_t)L * 128 * 64}, 256, 256, Wc2, scr, gw, NGW, lane); } }
        gsync(lds);
        { PHASE_PTRS; const float* xin = (L == 0) ? PIN(0) : X; ffn_gemms(lds, grid, ws, xin, X, G, bid, wv0); }
        { PHASE_PTRS;
        norm_rows(X, PIN(5) + L * DM, HN, gw, NGW, lane);
        conv_ffn(PIN(20) + (size_t)L * DM * DFF, PIN(21) + (size_t)L * DM * DFF, PIN(22) + (size_t)L * DFF * DM, Wgu, Wd, scr, gw, NGW, lane); }
        gsync(lds);
        for (int rep = 0; rep < REP_G2; ++rep) { PHASE_PTRS; pg8::Gemm g{HN, Win, MTOK, NPROJ, DM, DM, DM}; pg8::StaticOrder S; S.init(MTOK, NPROJ, G, bid); pg8::EpiBf16<0> E{PROJ, NPROJ, NPROJ}; pg8::gemm_phase(lds, g, S, E, wv0); }
        gsync(lds);
#ifndef X_NOPOST
        { PHASE_PTRS;
            const float* qn = PIN(7) + L * 256; const float* kvn = PIN(9) + L * 128; const float* gbias = PIN(11) + L * 18;
            const float* posk = PIN(12) + L * 2048; const float* posv = PIN(15) + L * 2048; const float* rt = WSP(float, WS_ROPE);
            if (gw < 8) {
                const size_t R = (gw < 4) ? (size_t)(2044 + gw) : (size_t)(2048 + 2044 + (gw - 4));
#pragma unroll
                for (int j = 0; j < 4; ++j) *(u32x4*)(FLAT + R * 2048 + (j * 64 + lane) * 8) = (u32x4){0u, 0u, 0u, 0u};
            }
            const f32x4 gq = ((const f32x4*)qn)[lane]; const f32x2 gkv = ((const f32x2*)kvn)[lane]; const float gb = lane < 18 ? gbias[lane] : 0.f;
            const int g_ = lane >> 5, pp = lane & 31;
            const int hdA = lane >> 3, iA = lane & 7, baseA = hdA < 6 ? PC_NQ + 64 * hdA : PC_KS + 64 * (hdA - 6);
            const int hdB = 8 + (lane >> 3), baseB = PC_KW + 64 * (hdB - 8);
            for (int mrow = gw; mrow < MTOK; mrow += NGW) {
                bf16_t* pr = PROJ + (size_t)mrow * NPROJ;
                const int b = mrow >> 13, spos = mrow & (SEQ - 1);
                const int j = spos >> 4, t16 = spos & 15;
                u32x2 wcq = *(const u32x2*)(pr + PC_CQ + 4 * lane);
                const unsigned wckv = *(const unsigned*)(pr + PC_CKV + 2 * lane);
                const unsigned wkr = *(const unsigned*)(pr + PC_KR + 2 * (lane & 15));
                const float ckr = rt[ROPE_MLA_COS + spos * 16 + (lane & 15)], skr = rt[ROPE_MLA_SIN + spos * 16 + (lane & 15)];
                const unsigned wA = *(const unsigned*)(pr + baseA + 2 * iA);
                const unsigned wB = *(const unsigned*)(pr + baseB + 2 * iA);
                const float cn = rt[ROPE_NSA_COS + spos * 8 + iA], sn = rt[ROPE_NSA_SIN + spos * 8 + iA];
                const float gatev = bf2f(pr[PC_GATE + (lane < 18 ? lane : 0)]);
                const unsigned wk = *(const unsigned*)(pr + PC_KC + 64 * g_ + 2 * pp);
                const unsigned wv = *(const unsigned*)(pr + PC_VC + 64 * g_ + 2 * pp);
                const float ck = rt[ROPE_NSA_COS + spos * 8 + (pp & 7)], sk = rt[ROPE_NSA_SIN + spos * 8 + (pp & 7)];
                const float pk00 = posk[t16 * 64 + perm64(2 * pp)], pk01 = posk[t16 * 64 + perm64(2 * pp + 1)];
                const float pk10 = posk[(16 + t16) * 64 + perm64(2 * pp)], pk11 = posk[(16 + t16) * 64 + perm64(2 * pp + 1)];
                const f32x2 pv0 = *(const f32x2*)(posv + t16 * 64 + 2 * pp), pv1 = *(const f32x2*)(posv + (16 + t16) * 64 + 2 * pp);
                { const float a0 = bflo(wcq.x), a1 = bfhi(wcq.x), a2 = bflo(wcq.y), a3 = bfhi(wcq.y);
                  const float b0 = bflo(wckv), b1 = bfhi(wckv);
                  const float r = rsqrtf(wave_sum((a0 * a0 + a1 * a1) + (a2 * a2 + a3 * a3)) * (1.f / 256.f) + EPS);
                  const float r2 = rsqrtf(wave_sum(b0 * b0 + b1 * b1) * (1.f / 128.f) + EPS);
                  wcq.x = cvtpk(a0 * r * gq.x, a1 * r * gq.y); wcq.y = cvtpk(a2 * r * gq.z, a3 * r * gq.w);
                  *(u32x2*)(pr + PC_CQ + 4 * lane) = wcq;
                  *(unsigned*)(pr + PC_CKV + 2 * lane) = cvtpk(b0 * r2 * gkv.x, b1 * r2 * gkv.y); }
                if (lane < 16) { const float x1 = bflo(wkr), x2 = bfhi(wkr); *(unsigned*)(pr + PC_KR + 2 * lane) = cvtpk(x1 * ckr - x2 * skr, x2 * ckr + x1 * skr); }
                { const float x1 = bflo(wA), x2 = bfhi(wA); *(unsigned*)(pr + baseA + 2 * iA) = cvtpk(x1 * cn - x2 * sn, x2 * cn + x1 * sn); }
                if (lane < 16) { const float x1 = bflo(wB), x2 = bfhi(wB); *(unsigned*)(pr + baseB + 2 * iA) = cvtpk(x1 * cn - x2 * sn, x2 * cn + x1 * sn); }
                if (lane < 18) GATES[(size_t)mrow * 32 + lane] = 1.f / (1.f + __expf(-(gatev + gb)));
                {
                    float k0 = bflo(wk), k1 = bfhi(wk);
                    if (pp < 8) { const float x1 = k0, x2 = k1; k0 = x1 * ck - x2 * sk; k1 = x2 * ck + x1 * sk; }
                    const float v0 = bflo(wv), v1 = bfhi(wv);
                    if (j < NCMP) { const size_t R = (size_t)(b * NCMP + j) * 2 + g_;
                        *(unsigned*)(FLAT + R * 2048 + t16 * 64 + 2 * pp) = cvtpk(k0 + pk00, k1 + pk01);
                        *(unsigned*)(FLAT + (2048 + R) * 2048 + t16 * 64 + 2 * pp) = cvtpk(v0 + pv0.x, v1 + pv0.y); }
                    if (j >= 1) { const size_t R = (size_t)(b * NCMP + j - 1) * 2 + g_;
                        *(unsigned*)(FLAT + R * 2048 + (16 + t16) * 64 + 2 * pp) = cvtpk(k0 + pk10, k1 + pk11);
                        *(unsigned*)(FLAT + (2048 + R) * 2048 + (16 + t16) * 64 + 2 * pp) = cvtpk(v0 + pv1.x, v1 + pv1.y); }
                }
            }
        }
#endif
        gsync(lds);
        for (int rep = 0; rep < REP_G2; ++rep) {
        { PHASE_PTRS; pg8::Gemm g{PROJ + PC_CQ, Wuq, MTOK, 768, 256, NPROJ, 256}; pg8::StaticOrder S; S.init(MTOK, 768, G, bid); pg8::EpiBf16<0> E{QMLA, 576, 576}; pg8::gemm_phase(lds, g, S, E, wv0); }
        { PHASE_PTRS; pg8::Gemm g{PROJ + PC_CKV, Wukv, MTOK, 768, 128, NPROJ, 128}; pg8::StaticOrder S; S.init(MTOK, 768, G, bid); pg8::EpiBf16<0> E{KVB, 768, 768}; pg8::gemm_phase(lds, g, S, E, wv0); }
        for (int ks = 0; ks < 4; ++ks) {
            PHASE_PTRS; pg8::Gemm g{FLAT + ks * 512, Wc1 + ks * 512, 4096, 256, 512, 2048, 2048}; pg8::StaticOrder S; S.init(4096, 256, G, (bid + G - 128 - 16 * ks) % G);
            pg8::EpiF32 E{WSP(float, WS_PART) + (size_t)ks * 4096 * 256, 256}; pg8::gemm_phase(lds, g, S, E, wv0); } }
        gsync(lds);
        { PHASE_PTRS;
            const f32x4* part = (const f32x4*)WSP(float, WS_PART);
            for (int e = bid * 512 + tid; e < 4096 * 64; e += G * 512) {
                f32x4 a = part[e] + part[e + (size_t)4096 * 64] + part[e + (size_t)2 * 4096 * 64] + part[e + (size_t)3 * 4096 * 64];
#pragma unroll
                for (int i = 0; i < 4; ++i) { const float x = a[i], y = 0.7978845608028654f * (x + 0.044715f * x * x * x); a[i] = x * __builtin_amdgcn_rcpf(1.f + __expf(-2.f * y)); }
                u32x2 w; w.x = cvtpk(a[0], a[1]); w.y = cvtpk(a[2], a[3]);
                *(u32x2*)(HID + (size_t)e * 4) = w;
            }
        }
        gsync(lds);
        { PHASE_PTRS; pg8::Gemm g{HID, Wc2, 4096, 256, 256, 256, 256}; pg8::StaticOrder S; S.init(4096, 256, G, bid); pg8::EpiBf16<0> E{KCVC, 256, 256}; pg8::gemm_phase(lds, g, S, E, wv0); }
        gsync(lds);
#ifndef X_NOA1
        { PHASE_PTRS;
            unsigned* ctr = WSP(unsigned, WS_CTL) + 64 * (1 + 2 * L);
            const int r32 = lane & 31, hi = lane >> 5;
            for (;;) {
                __syncthreads();
                if (tid == 0) *s_item = (int)atomicAdd(ctr, 1u);
                __syncthreads();
                const int it = *s_item;
                if (it >= 384) break;
                const int qb = 31 - it / 12, bh = it % 12, b = bh / 6, h = bh % 6, g = h / 3, q0 = qb * 256;
                const size_t rb = (size_t)b * SEQ;
                const int cmax = (q0 + 224) >> 4, t1 = (cmax >> 6) + 1;
                const float gate = GATES[(rb + q0 + 32 * wid + r32) * 32 + h * 3 + 0];
                f32x16 tot[2]; tot[0] = (f32x16){}; tot[1] = (f32x16){};
                flash_unit<64, MODE_CMP>(lds, wv0, PROJ + (rb + q0) * NPROJ + PC_NQ + 64 * h, NPROJ, KCVC + ((size_t)(b * NCMP) * 2 + g) * 256, 512, nullptr, 0,
                                         KCVC + ((size_t)2048 + (size_t)(b * NCMP) * 2 + g) * 256 + 64, 512, q0, 0, t1, 0.125f * LOG2E, (u32x4){}, gate, tot,
                                         LSE + (size_t)(b * 6 + h) * SEQ + q0);
                store_o(tot, OCMP + (rb + q0 + 32 * wid + r32) * 384 + h * 64, hi);
            }
        }
#endif
        gsync(lds);
#ifndef X_NOA2A
        { PHASE_PTRS;
            const int r32 = lane & 31, hi = lane >> 5;
            LAS unsigned char* Ks = lds + AT_K;
            for (int it_ = bid; it_ < 256 * REP_A2; it_ += G) {
                const int thalf = it_ & 1, it = (it_ >> 1) & 127;
                const int qb = it >> 2, b = (it >> 1) & 1, g = it & 1, q0 = qb * 256;
                const size_t rb = (size_t)b * SEQ;
                const int qpos = q0 + 32 * wid + r32, qmaxw = q0 + 32 * wid + 31;
                const int cmax = (q0 + 224) >> 4, t1 = (cmax >> 6) + 1;
                bf16x8 qf[3][4]; float lse[3];
#pragma unroll
                for (int r = 0; r < 3; ++r) {
                    const int h = 3 * g + r;
#pragma unroll
                    for (int ks = 0; ks < 4; ++ks) qf[r][ks] = *(const bf16x8*)(PROJ + (rb + qpos) * NPROJ + PC_NQ + 64 * h + 16 * ks + 8 * hi);
                    lse[r] = LSE[(size_t)(b * 6 + h) * SEQ + qpos];
                }
                const bf16_t* K1 = KCVC + ((size_t)(b * NCMP) * 2 + g) * 256;
                const int srow = tid >> 3, sch = tid & 7;
                float* s1row = S1 + ((size_t)(b * 2 + g) * SEQ + qpos) * 128; float* s2row = S2 + ((size_t)(b * 2 + g) * SEQ + qpos) * 128;
                for (int t = thalf; t < t1; t += 2) {
                    __syncthreads();
                    *(LAS u32x4*)(Ks + srow * 144 + sch * 16) = *(const u32x4*)(K1 + ((size_t)64 * t + srow) * 512 + sch * 8);
                    __syncthreads();
                    if (16 * (64 * t) + 31 > qmaxw) continue;
#pragma unroll
                    for (int kb = 0; kb < 2; ++kb) {
                        f32x16 ps = (f32x16){};
#pragma unroll
                        for (int r = 0; r < 3; ++r) {
                            f32x16 s = (f32x16){};
#pragma unroll
                            for (int ks = 0; ks < 4; ++ks) { const bf16x8 a = *(const LAS bf16x8*)(Ks + (32 * kb + r32) * 144 + ks * 32 + hi * 16); s = MFMA32(a, qf[r][ks], s); }
#pragma unroll
                            for (int i = 0; i < 16; ++i) { const int c = 64 * t + 32 * kb + crow(i, hi); const bool valid = (16 * c + 31 <= qpos); ps[i] += valid ? exp2f(s[i] * (0.125f * LOG2E) - lse[r]) : 0.f; }
                        }
#pragma unroll
                        for (int j = 0; j < 4; ++j) { const int n = 16 * t + 8 * kb + 2 * j + hi; s1row[n] = (ps[4 * j] + ps[4 * j + 1]) + (ps[4 * j + 2] + ps[4 * j + 3]); s2row[n] = ps[4 * j + 3]; }
                    }
                }
            }
        }
#endif
        gsync(lds);
#ifndef X_NOA2B
        { PHASE_PTRS;
#define TK_LOAD(IT, K0, K1) do { const int q_ = (IT) & (SEQ - 1), cur_ = q_ >> 6; K0 = 0u; K1 = 0u; \
            if (cur_ > 15) { const float* s1_ = S1 + (size_t)(IT) * 128; const float* s2_ = S2 + (size_t)(IT) * 128; \
                const bool c0_ = lane >= 1 && lane <= cur_ - 2, c1_ = lane + 64 <= cur_ - 2; \
                if (c0_) K0 = __float_as_uint(s1_[lane] + s2_[lane - 1]) + 1u; \
                if (c1_) K1 = __float_as_uint(s1_[lane + 64] + s2_[lane + 63]) + 1u; } } while (0)
            const int NIT = 2 * 2 * SEQ * REP_A2;
            for (int itA_ = gw; itA_ < NIT; itA_ += 2 * NGW) {
                const int itB_ = itA_ + NGW;
                const int itA = itA_ & (2 * 2 * SEQ - 1), itB = itB_ & (2 * 2 * SEQ - 1);
                const bool hasB = itB_ < NIT;
                unsigned a0 = 0u, a1 = 0u, c0 = 0u, c1 = 0u;
                TK_LOAD(itA, a0, a1);
                if (hasB) TK_LOAD(itB, c0, c1);
                const int curA = (itA & (SEQ - 1)) >> 6, curB = (itB & (SEQ - 1)) >> 6;
                unsigned TA = 0u, TB = 0u;
                for (int bit = 30; bit >= 0; --bit) {
                    const unsigned trA = TA | (1u << bit), trB = TB | (1u << bit);
                    const int cA = __popcll(__ballot(a0 >= trA)) + __popcll(__ballot(a1 >= trA));
                    const int cB = __popcll(__ballot(c0 >= trB)) + __popcll(__ballot(c1 >= trB));
                    if (cA >= 13) TA = trA;
                    if (cB >= 13) TB = trB;
                }
#define TK_FINISH(IT, CUR, K0, K1, T) do { unsigned long long b0_ = 0ull, b1_ = 0ull; \
                    if ((CUR) <= 15) { b0_ = (2ull << (CUR)) - 1ull; } \
                    else { b0_ = __ballot((K0) > (T)); b1_ = __ballot((K1) > (T)); int need_ = 13 - __popcll(b0_) - __popcll(b1_); \
                        unsigned long long e0_ = __ballot((K0) == (T)), e1_ = __ballot((K1) == (T)); \
                        while (need_ > 0) { if (e0_) { const unsigned long long low_ = e0_ & (0ull - e0_); b0_ |= low_; e0_ ^= low_; } \
                                            else { const unsigned long long low_ = e1_ & (0ull - e1_); b1_ |= low_; e1_ ^= low_; } --need_; } \
                        b0_ |= 1ull; \
                        if ((CUR) < 64) b0_ |= 1ull << (CUR); else b1_ |= 1ull << ((CUR) - 64); \
                        if ((CUR) - 1 < 64) b0_ |= 1ull << ((CUR) - 1); else b1_ |= 1ull << ((CUR) - 65); } \
                    if (lane == 0) *(u32x4*)(MASKS + (size_t)(IT) * 4) = (u32x4){(unsigned)b0_, (unsigned)(b0_ >> 32), (unsigned)b1_, (unsigned)(b1_ >> 32)}; } while (0)
                TK_FINISH(itA, curA, a0, a1, TA);
                if (hasB) TK_FINISH(itB, curB, c0, c1, TB);
#undef TK_FINISH
            }
#undef TK_LOAD
        }
#endif
        gsync(lds);
#ifndef X_NOA3
        { PHASE_PTRS;
            unsigned* ctr = WSP(unsigned, WS_CTL) + 64 * (2 + 2 * L);
            const int r32 = lane & 31, hi = lane >> 5;
            for (;;) {
                __syncthreads();
                if (tid == 0) *s_item = (int)atomicAdd(ctr, 1u);
                __syncthreads();
                const int it = *s_item;
                if (it >= 1024) break;
                if (it >= 768) {
                    const int k = it - 768, qb = 31 - k / 8, bh = k % 8, b = bh >> 2, h = bh & 3, q0 = qb * 256;
                    const size_t rb = (size_t)b * SEQ;
                    f32x16 tot[2]; tot[0] = (f32x16){}; tot[1] = (f32x16){};
                    sb_unit(lds, wv0, PROJ + (rb + q0) * NPROJ + PC_SBQ + 64 * h, PROJ + rb * NPROJ + PC_SBK + 64 * h, PROJ + rb * NPROJ + PC_SBV + 64 * h, q0, tot);
                    store_o(tot, HN + (rb + q0 + 32 * wid + r32) * DM + 768 + h * 64, hi);
                    continue;
                }
                const int qb = 31 - it / 24, r24 = it % 24, bh = r24 % 12, b = bh / 6, h = bh % 6, g = h / 3, q0 = qb * 256;
                const size_t rb = (size_t)b * SEQ; const size_t qrow = rb + q0 + 32 * wid + r32;
                if (r24 < 12) {
                    f32x16 tot[2]; tot[0] = (f32x16){}; tot[1] = (f32x16){};
                    flash_unit<96, MODE_CAUSAL>(lds, wv0, QMLA + (rb + q0) * 576 + h * 96, 576, KVB + rb * 768 + h * 64, 768, PROJ + rb * NPROJ + PC_KR, NPROJ,
                                                KVB + rb * 768 + 384 + h * 64, 768, q0, 0, (q0 + 256) / 64, 0.10206207261596577f * LOG2E, (u32x4){}, 1.f, tot, nullptr, WSP(float, WS_ROPE));
                    store_o(tot, HN + qrow * DM + h * 64, hi);
                } else {
                    const float g1 = GATES[qrow * 32 + h * 3 + 1], g2 = GATES[qrow * 32 + h * 3 + 2];
                    const u32x4 mw = *(const u32x4*)(MASKS + ((size_t)(b * 2 + g) * SEQ + q0 + 32 * wid + r32) * 4);
                    f32x16 tot[2];
                    { const bf16_t* oc = OCMP + qrow * 384 + h * 64;
#pragma unroll
                      for (int d0 = 0; d0 < 2; ++d0)
#pragma unroll
                          for (int j = 0; j < 4; ++j) { const u32x2 w = *(const u32x2*)(oc + 32 * d0 + 8 * j + 4 * hi); tot[d0][4 * j] = bflo(w.x); tot[d0][4 * j + 1] = bfhi(w.x); tot[d0][4 * j + 2] = bflo(w.y); tot[d0][4 * j + 3] = bfhi(w.y); } }
                    const bf16_t* Qp = PROJ + (rb + q0) * NPROJ + PC_NQ + 64 * h;
                    flash_unit<64, MODE_SEL>(lds, wv0, Qp, NPROJ, PROJ + rb * NPROJ + PC_KS + 64 * g, NPROJ, nullptr, 0, PROJ + rb * NPROJ + PC_VS + 64 * g, NPROJ,
                                             q0, 0, (q0 + 256) / 64, 0.125f * LOG2E, mw, g1, tot, nullptr);
                    const int tw0 = (q0 >= 512) ? (q0 - 512) / 64 : 0;
                    flash_unit<64, MODE_WIN>(lds, wv0, Qp, NPROJ, PROJ + rb * NPROJ + PC_KW + 64 * g, NPROJ, nullptr, 0, PROJ + rb * NPROJ + PC_VW + 64 * g, NPROJ,
                                             q0, tw0, (q0 + 256) / 64, 0.125f * LOG2E, (u32x4){}, g2, tot, nullptr);
                    store_o(tot, HN + qrow * DM + 384 + h * 64, hi);
                }
            }
        }
#endif
        gsync(lds);
        { PHASE_PTRS; pg8::Gemm g{HN, Wout, MTOK, DM, DM, DM, DM}; pg8::StaticOrder S; S.init(MTOK, DM, G, bid); pg8::EpiResid E{X, X, DM, 1.0f}; pg8::gemm_phase(lds, g, S, E, wv0); }
        gsync(lds);
        { PHASE_PTRS; norm_rows(X, PIN(19) + L * DM, HN, gw, NGW, lane); }
        gsync(lds);
        { PHASE_PTRS; ffn_gemms(lds, grid, ws, X, X, G, bid, wv0); }
    }
    float* X = GET_X(); const float* fng = PIN(23); const int G = fresh_s(G0), bid = fresh_s(bid0), NGW = G * 8;
    const int tid = fresh_tid2(wv0), lane = tid & 63, wid = wv0, gw = bid * 8 + wid;
    for (int mrow = gw; mrow < MTOK; mrow += NGW) {
        f32x4* xr = (f32x4*)(X + (size_t)mrow * DM) + lane;
        f32x4 v[4]; float ss = 0.f;
#pragma unroll
        for (int j = 0; j < 4; ++j) { v[j] = xr[64 * j]; ss += (v[j].x * v[j].x + v[j].y * v[j].y) + (v[j].z * v[j].z + v[j].w * v[j].w); }
        const float r = rsqrtf(wave_sum(ss) * (1.f / DM) + EPS);
#pragma unroll
        for (int j = 0; j < 4; ++j) { const f32x4 gg = ((const f32x4*)fng)[lane + 64 * j]; xr[64 * j] = v[j] * r * gg; }
    }
}

#undef lds
extern "C" void kernel_launch(void* const* d_in, const int* in_sizes, int n_in, void* d_out, int out_size, void* d_ws, size_t ws_size, hipStream_t stream) {
    static int grid = 0;
    if (grid == 0) {
        if (n_in != 24 || out_size != MTOK * DM || ws_size < WS_END) { fprintf(stderr, "kernel_launch: unexpected shapes (n_in %d out %d ws %zu)\n", n_in, out_size, ws_size); grid = -1; return; }
        int dev = 0, cus = 0, per_cu = 0;
        hipGetDevice(&dev);
        hipDeviceGetAttribute(&cus, hipDeviceAttributeMultiprocessorCount, dev);
        hipFuncSetAttribute((const void*)mega_fwd, hipFuncAttributeMaxDynamicSharedMemorySize, LDS_BYTES);
        hipOccupancyMaxActiveBlocksPerMultiprocessor(&per_cu, (const void*)mega_fwd, 512, LDS_BYTES);
        if (per_cu < 1) per_cu = 1;
        grid = cus * 1;
        (void)hipGetLastError();
    }
    if (grid < 0) return;
    hipMemsetAsync((char*)d_ws + WS_CTL, 0, 65536, stream);
    Params p{};
    for (int i = 0; i < 24; ++i) p.in[i] = (const float*)d_in[i];
    p.out = (float*)d_out; p.ws = (unsigned char*)d_ws;
    void* args[] = {&p};
    hipError_t e = hipLaunchCooperativeKernel((const void*)mega_fwd, dim3(grid), dim3(512), args, LDS_BYTES, stream);
    if (e != hipSuccess) fprintf(stderr, "cooperative launch failed: %s (grid %d)\n", hipGetErrorString(e), grid);
}
```

```cpp
#include <hip/hip_runtime.h>
#include <hip/hip_cooperative_groups.h>
#include <cstdio>
#include <cstdint>
namespace cg = cooperative_groups;
#ifndef GS_REP
#define GS_REP 1
#endif
#ifndef REP_A2
#define REP_A2 1
#endif
#ifndef REP_NORM
#define REP_NORM 1
#endif
#ifndef REP_G2
#define REP_G2 1
#endif
#ifndef REP_A1
#define REP_A1 1
#endif
#ifndef REP_A3
#define REP_A3 1
#endif
#ifndef REP_FFN
#define REP_FFN 1
#endif
#ifndef REP_CONV
#define REP_CONV 1
#endif

#define LAS __attribute__((address_space(3)))
typedef unsigned short bf16_t;
typedef short bf16x8 __attribute__((ext_vector_type(8)));
typedef short s16x4 __attribute__((ext_vector_type(4)));
typedef float f32x2 __attribute__((ext_vector_type(2)));
typedef float f32x4 __attribute__((ext_vector_type(4)));
typedef float f32x16 __attribute__((ext_vector_type(16)));
typedef unsigned u32x2 __attribute__((ext_vector_type(2)));
typedef unsigned u32x4 __attribute__((ext_vector_type(4)));
typedef __bf16 bf16x2_t __attribute__((ext_vector_type(2)));
#define DI __device__ __forceinline__

constexpr int SEQ = 8192, BATCH = 2, MTOK = BATCH * SEQ, DM = 1024, DFF = 2816, DIN = 2354, NPROJ = 2560;
constexpr int NCMP = 511;
constexpr float EPS = 1e-6f;
constexpr float LOG2E = 1.4426950408889634f;
constexpr int PC_CQ = 0, PC_CKV = 256, PC_KR = 384, PC_NQ = 416, PC_KC = 800, PC_VC = 928, PC_KS = 1056, PC_VS = 1184, PC_KW = 1312, PC_VW = 1440,
              PC_SBQ = 1568, PC_SBK = 1824, PC_SBV = 2080, PC_GATE = 2336;
constexpr size_t MiB = 1u << 20;
constexpr size_t WS_CTL = 0, WS_WGU = 1 * MiB, WS_WD = 12 * MiB, WS_WIN = 18 * MiB, WS_WOUT = 23 * MiB, WS_WC1 = 25 * MiB, WS_WUQ = 26 * MiB,
                 WS_WUKV = 26 * MiB + 512 * 1024, WS_WC2 = 26 * MiB + 768 * 1024, WS_HN = 28 * MiB, WS_R = 60 * MiB, WS_GATES = 140 * MiB,
                 WS_MASK = 142 * MiB, WS_LSE = 142 * MiB + 512 * 1024, WS_HID = 143 * MiB, WS_KCVC = 145 * MiB, WS_QMLA = 148 * MiB,
                 WS_KVB = 166 * MiB, WS_OCMP = 190 * MiB, WS_FLAT = 202 * MiB, WS_S1 = 202 * MiB, WS_S2 = 218 * MiB, WS_ROPE = 234 * MiB, WS_PART = 236 * MiB, WS_END = 252 * MiB;
constexpr size_t ROPE_MLA_COS = 0, ROPE_MLA_SIN = 8192 * 16, ROPE_NSA_COS = 2 * 8192 * 16, ROPE_NSA_SIN = 2 * 8192 * 16 + 8192 * 8;
constexpr int LDS_BYTES = 131072 + 1024;
constexpr int PTAB = 131072 + 64;

DI unsigned cvtpk(float lo, float hi) { f32x2 v = {lo, hi}; bf16x2_t b = __builtin_convertvector(v, bf16x2_t); return __builtin_bit_cast(unsigned, b); }
DI float bf2f(unsigned short h) { return __uint_as_float(((unsigned)h) << 16); }
DI float bflo(unsigned w) { return __uint_as_float(w << 16); }
DI float bfhi(unsigned w) { return __uint_as_float(w & 0xffff0000u); }
DI int fresh_tid() { int t = threadIdx.x; asm volatile("" : "+v"(t)); return t; }
DI int fresh_tid2(int wv) { unsigned z_ = 0u; asm volatile("" : "+v"(z_)); const int l_ = (int)__builtin_amdgcn_mbcnt_hi(~0u, __builtin_amdgcn_mbcnt_lo(~0u, z_)); return (wv << 6) | l_; }
DI LAS unsigned char* fresh_lds(LAS unsigned char* p) { asm volatile("" : "+s"(p)); return p; }
DI int fresh_s(int x) { asm volatile("" : "+s"(x)); return x; }
DI int perm32(int p) { return (p & 1) ? (p >> 1) + 16 : (p >> 1); }
DI int perm64(int p) { return p < 16 ? ((p & 1) ? (p >> 1) + 8 : (p >> 1)) : p; }
#define SWZ(v, x) __int_as_float(__builtin_amdgcn_ds_swizzle(__float_as_int(v), (((x) << 10) | 0x1f)))
DI float half_sum(float v) { auto rr = __builtin_amdgcn_permlane32_swap(__float_as_uint(v), __float_as_uint(v), false, false); return __uint_as_float(rr[0]) + __uint_as_float(rr[1]); }
DI float half_max(float v) { auto rr = __builtin_amdgcn_permlane32_swap(__float_as_uint(v), __float_as_uint(v), false, false); return fmaxf(__uint_as_float(rr[0]), __uint_as_float(rr[1])); }
DI float half_other(float v, int hi) { auto rr = __builtin_amdgcn_permlane32_swap(__float_as_uint(v), __float_as_uint(v), false, false); return __uint_as_float(hi ? rr[0] : rr[1]); }
DI float wave_sum(float v) {
    v += SWZ(v, 1); v += SWZ(v, 2); v += SWZ(v, 4); v += SWZ(v, 8); v += SWZ(v, 16);
    return half_sum(v);
}
DI void rope_cs(int pos, float inv_freq, float& c, float& s) {
    const float ang = (float)pos * inv_freq;
    double rev = (double)ang * 0.15915494309189535; rev -= __builtin_rint(rev);
    const float r = (float)rev; c = __builtin_amdgcn_cosf(r); s = __builtin_amdgcn_sinf(r);
}
DI float inv_freq_of(int i, float inv_half) { return exp2f(-(float)i * inv_half * 18.931568569324174f); }

namespace pg8 {
constexpr int BM = 256, BK = 64, HALF = 128, HTB = HALF * BK * 2, STAGE_BYTES = 8 * HTB, NXCD = 8, WGM = 4;
DI int lds_byte(int r, int c) { const int st = (r >> 4) * 2 + (c >> 5), rr = r & 15, cc = c & 31, ob = rr * 64 + cc * 2; return st * 1024 + (ob ^ (((ob >> 9) & 1) << 5)); }
DI void stage_rc(int b, int& R, int& C) { const int st = b / 1024, sb = b % 1024, swz = sb ^ (((sb >> 9) & 1) << 5); R = (st >> 1) * 16 + swz / 64; C = (st & 1) * 32 + (swz % 64) / 2; }
DI int perm32r(int rho) { const int n = rho >> 4, i = rho & 15; return 8 * (i >> 2) + 4 * n + (i & 3); }
struct Unit { int pm, pn; };
struct Gemm { const bf16_t* A; const bf16_t* Bt; int M, N, K, lda, ldb; };
struct StaticOrder {
    int nM, nN, nwg, G, c;
    DI void init(int M, int N, int G_, int c_) { nM = M / BM; nN = N / BM; nwg = nM * nN; G = G_; c = c_; }
    DI bool next(int i, Unit& u) const {
        const long L = (long)i * G + c; if (L >= nwg) return false;
        int wgid = (int)L; { const int q = nwg / NXCD, r = nwg % NXCD, xcd = wgid % NXCD, off = wgid / NXCD; wgid = (xcd < r ? xcd * (q + 1) : r * (q + 1) + (xcd - r) * q) + off; }
        const int nig = WGM * nN, gid = wgid / nig, fm = gid * WGM, gsz = (nM - fm) < WGM ? (nM - fm) : WGM;
        u.pm = fm + ((wgid % nig) % gsz); u.pn = (wgid % nig) / gsz; return true;
    }
};
typedef f32x4 Acc[2][2][4][2];

struct EpiSwiGLU {
    static constexpr bool PERM = true;
    bf16_t* O; int ldc;
    DI void operator()(const Acc& acc, const Unit& u, int wr, int wc, int fr, int fq) const {
        const int row0 = u.pm * BM + wr * 64 + fr, col0 = u.pn * HALF + wc * 32 + 8 * fq;
#pragma unroll
        for (int ai = 0; ai < 2; ++ai)
#pragma unroll
            for (int m = 0; m < 4; ++m) {
                bf16_t* rowp = O + (size_t)(row0 + ai * HALF + m * 16) * ldc + col0;
                float v[8];
#pragma unroll
                for (int n = 0; n < 2; ++n)
#pragma unroll
                    for (int i = 0; i < 4; ++i) { const float g = acc[ai][0][m][n][i], up = acc[ai][1][m][n][i]; v[n * 4 + i] = g * __builtin_amdgcn_rcpf(1.f + __expf(-g)) * up; }
                u32x4 w; w.x = cvtpk(v[0], v[1]); w.y = cvtpk(v[2], v[3]); w.z = cvtpk(v[4], v[5]); w.w = cvtpk(v[6], v[7]);
                *(u32x4*)rowp = w;
                asm volatile("" ::: "memory");
            }
    }
};
struct EpiResid {
    static constexpr bool PERM = false;
    const float* base; float* out; int ldc; float alpha;
    DI void operator()(const Acc& acc, const Unit& u, int wr, int wc, int fr, int fq) const {
        const int row0 = u.pm * BM + wr * 64 + fr, col0 = u.pn * BM + wc * 32 + 4 * fq;
#pragma unroll
        for (int ai = 0; ai < 2; ++ai)
#pragma unroll
            for (int m = 0; m < 4; ++m) {
                const size_t off = (size_t)(row0 + ai * HALF + m * 16) * ldc + col0;
#pragma unroll
                for (int bj = 0; bj < 2; ++bj)
#pragma unroll
                    for (int n = 0; n < 2; ++n) { const f32x4 b = *(const f32x4*)(base + off + bj * HALF + n * 16); *(f32x4*)(out + off + bj * HALF + n * 16) = b + acc[ai][bj][m][n] * alpha; }
                asm volatile("" ::: "memory");
            }
    }
};
struct EpiF32 {
    static constexpr bool PERM = false;
    float* O; int ldc;
    DI void operator()(const Acc& acc, const Unit& u, int wr, int wc, int fr, int fq) const {
        const int row0 = u.pm * BM + wr * 64 + fr, col0 = u.pn * BM + wc * 32 + 4 * fq;
#pragma unroll
        for (int ai = 0; ai < 2; ++ai)
#pragma unroll
            for (int m = 0; m < 4; ++m) {
                const size_t off = (size_t)(row0 + ai * HALF + m * 16) * ldc + col0;
#pragma unroll
                for (int bj = 0; bj < 2; ++bj)
#pragma unroll
                    for (int n = 0; n < 2; ++n) *(f32x4*)(O + off + bj * HALF + n * 16) = acc[ai][bj][m][n];
                asm volatile("" ::: "memory");
            }
    }
};
template <int ACT> struct EpiBf16 {
    static constexpr bool PERM = true;
    bf16_t* O; int ldc; int ncols;
    DI void operator()(const Acc& acc, const Unit& u, int wr, int wc, int fr, int fq) const {
        const int row0 = u.pm * BM + wr * 64 + fr, col0 = u.pn * BM + wc * 32 + 8 * fq;
#pragma unroll
        for (int ai = 0; ai < 2; ++ai)
#pragma unroll
            for (int m = 0; m < 4; ++m) {
                bf16_t* rowp = O + (size_t)(row0 + ai * HALF + m * 16) * ldc + col0;
#pragma unroll
                for (int bj = 0; bj < 2; ++bj) {
                    if (col0 + bj * HALF >= ncols) continue;
                    float v[8];
#pragma unroll
                    for (int n = 0; n < 2; ++n)
#pragma unroll
                        for (int i = 0; i < 4; ++i) { float x = acc[ai][bj][m][n][i];
                            if (ACT == 2) { const float y = 0.7978845608028654f * (x + 0.044715f * x * x * x); x = x * __builtin_amdgcn_rcpf(1.f + __expf(-2.f * y)); }
                            v[n * 4 + i] = x; }
                    u32x4 w; w.x = cvtpk(v[0], v[1]); w.y = cvtpk(v[2], v[3]); w.z = cvtpk(v[4], v[5]); w.w = cvtpk(v[6], v[7]);
                    *(u32x4*)(rowp + bj * HALF) = w;
                }
                asm volatile("" ::: "memory");
            }
    }
};
template <class Epi>
DI void gemm_phase(LAS unsigned char* lds, const Gemm g, const StaticOrder& S, const Epi& E, int wv0) {
    const int tid = fresh_tid2(wv0), wid = __builtin_amdgcn_readfirstlane(tid >> 6), lane = tid & 63, wr = wid >> 2, wc = wid & 3, fr = lane & 15, fq = lane >> 4;
    const int K = g.K, nt = K / BK;
    unsigned voffA[2], voffB[2];
#pragma unroll
    for (int i = 0; i < 2; ++i) { int R, C; stage_rc(tid * 16 + i * 8192, R, C); const int Rb = Epi::PERM ? ((R & ~31) + perm32r(R & 31)) : R;
        voffA[i] = (unsigned)(R * g.lda + C) * 2u; voffB[i] = (unsigned)(Rb * g.ldb + C) * 2u; }
    const size_t kstep = (size_t)(BK * 2);
    const size_t hstepA = (size_t)HALF * g.lda * 2, hstepB = (size_t)HALF * g.ldb * 2;
    const size_t tstepA = 2 * hstepA, tstepB = 2 * hstepB;
    const unsigned ldsw = (unsigned)wid * 1024u;
    const int aoff = lds_byte(wr * 64 + fr, fq * 8), boff = lds_byte(wc * 32 + fr, fq * 8);
#define PG8_SA(b, h) (((b) * 2 + (h)) * HTB)
#define PG8_SB(b, h) ((4 + (b) * 2 + (h)) * HTB)
#define PG8_STAGE(bufoff, gbase, voff) do { _Pragma("unroll") for (int _i = 0; _i < 2; ++_i) \
        __builtin_amdgcn_global_load_lds((const unsigned*)((const char*)(gbase) + (voff)[_i]), (LAS unsigned*)(lds + (bufoff) + ldsw + _i * 8192), 16, 0, 0); } while (0)
#define PG8_LDA(dst, b, h) do { _Pragma("unroll") for (int m = 0; m < 4; ++m) _Pragma("unroll") for (int k = 0; k < 2; ++k) dst[m][k] = *(const LAS bf16x8*)(lds + PG8_SA(b, h) + aoff + m * 2048 + k * 1024); } while (0)
#define PG8_LDB(dst, b, h) do { _Pragma("unroll") for (int n = 0; n < 2; ++n) _Pragma("unroll") for (int k = 0; k < 2; ++k) dst[n][k] = *(const LAS bf16x8*)(lds + PG8_SB(b, h) + boff + n * 2048 + k * 1024); } while (0)
#define PG8_MMA(ai, bj, At, Bt) do { __builtin_amdgcn_s_setprio(1); _Pragma("unroll") for (int m = 0; m < 4; ++m) _Pragma("unroll") for (int n = 0; n < 2; ++n) _Pragma("unroll") for (int k = 0; k < 2; ++k) \
        acc[ai][bj][m][n] = __builtin_amdgcn_mfma_f32_16x16x32_bf16(Bt[n][k], At[m][k], acc[ai][bj][m][n], 0, 0, 0); __builtin_amdgcn_s_setprio(0); } while (0)
#define PG8_WAIT_V(n) asm volatile("s_waitcnt vmcnt(" #n ")" ::: "memory")
#define PG8_WAIT_L(n) asm volatile("s_waitcnt lgkmcnt(" #n ")" ::: "memory")
#define PG8_BAR __builtin_amdgcn_s_barrier()
#define PG8_SCHED __builtin_amdgcn_sched_barrier(0)
    Unit cur, nxt; int ui = 0;
    if (!S.next(0, cur)) return;
    Acc acc;
#pragma unroll
    for (int a = 0; a < 2; ++a)
#pragma unroll
        for (int b = 0; b < 2; ++b)
#pragma unroll
            for (int m = 0; m < 4; ++m)
#pragma unroll
                for (int n = 0; n < 2; ++n) acc[a][b][m][n] = (f32x4){0.f, 0.f, 0.f, 0.f};
    bf16x8 At[4][2], B0[2][2], B1[2][2];
    const char* cA = (const char*)g.A + (size_t)cur.pm * tstepA; const char* cB = (const char*)g.Bt + (size_t)cur.pn * tstepB;
    PG8_STAGE(PG8_SB(0, 0), cB, voffB); PG8_STAGE(PG8_SB(0, 1), cB + hstepB, voffB); PG8_STAGE(PG8_SA(0, 0), cA, voffA); PG8_STAGE(PG8_SA(0, 1), cA + hstepA, voffA);
    if (wr == 1) PG8_BAR;
    PG8_WAIT_V(2); PG8_BAR;
    PG8_STAGE(PG8_SB(1, 0), cB + kstep, voffB); PG8_STAGE(PG8_SA(1, 0), cA + kstep, voffA); PG8_STAGE(PG8_SB(1, 1), cB + hstepB + kstep, voffB);
    PG8_WAIT_V(6); PG8_BAR;
    for (;;) {
        const bool has_next = S.next(ui + 1, nxt);
        const char* nA = has_next ? (const char*)g.A + (size_t)nxt.pm * tstepA : cA; const char* nB = has_next ? (const char*)g.Bt + (size_t)nxt.pn * tstepB : cB;
        for (int t = 0; t < nt; t += 2) {
            const bool last = (t == nt - 2);
            const char* a1 = cA + (size_t)(t + 1) * kstep;
            const char* a2 = last ? nA : cA + (size_t)(t + 2) * kstep; const char* b2 = last ? nB : cB + (size_t)(t + 2) * kstep;
            const char* a3 = a2 + kstep; const char* b3 = b2 + kstep;
            PG8_LDB(B0, 0, 0); PG8_LDB(B1, 0, 1); PG8_SCHED; PG8_LDA(At, 0, 0); PG8_STAGE(PG8_SA(1, 1), a1 + hstepA, voffA);
            PG8_WAIT_V(8); PG8_WAIT_L(0); PG8_BAR; PG8_MMA(0, 0, At, B0); PG8_MMA(0, 1, At, B1); PG8_BAR; PG8_SCHED;
            PG8_LDA(At, 0, 1); PG8_STAGE(PG8_SB(0, 0), b2, voffB); PG8_STAGE(PG8_SB(0, 1), b2 + hstepB, voffB); PG8_STAGE(PG8_SA(0, 0), a2, voffA);
            PG8_WAIT_V(8); PG8_WAIT_L(0); PG8_BAR; PG8_MMA(1, 0, At, B0); PG8_MMA(1, 1, At, B1); PG8_BAR; PG8_SCHED;
            PG8_LDB(B0, 1, 0); PG8_LDB(B1, 1, 1); PG8_SCHED; PG8_LDA(At, 1, 0); PG8_STAGE(PG8_SA(0, 1), a2 + hstepA, voffA);
            PG8_WAIT_V(8); PG8_WAIT_L(0); PG8_BAR; PG8_MMA(0, 0, At, B0); PG8_MMA(0, 1, At, B1); PG8_BAR; PG8_SCHED;
            PG8_LDA(At, 1, 1); PG8_STAGE(PG8_SB(1, 0), b3, voffB); PG8_STAGE(PG8_SB(1, 1), b3 + hstepB, voffB); PG8_STAGE(PG8_SA(1, 0), a3, voffA);
            PG8_WAIT_V(8); PG8_WAIT_L(0); PG8_BAR; PG8_MMA(1, 0, At, B0); PG8_MMA(1, 1, At, B1); PG8_BAR; PG8_SCHED;
        }
        if (wr == 0) PG8_BAR;
        { const int l2_ = fresh_tid2(wv0) & 63; E(acc, cur, wr, wc, l2_ & 15, l2_ >> 4); }
        if (!has_next) break;
#pragma unroll
        for (int a = 0; a < 2; ++a)
#pragma unroll
            for (int b = 0; b < 2; ++b)
#pragma unroll
                for (int m = 0; m < 4; ++m)
#pragma unroll
                    for (int n = 0; n < 2; ++n) acc[a][b][m][n] = (f32x4){0.f, 0.f, 0.f, 0.f};
        cur = nxt; cA = nA; cB = nB; ++ui;
        if (wr == 1) PG8_BAR;
    }
    PG8_WAIT_V(0);
    PG8_BAR;
#undef PG8_SA
#undef PG8_SB
#undef PG8_STAGE
#undef PG8_LDA
#undef PG8_LDB
#undef PG8_MMA
#undef PG8_WAIT_V
#undef PG8_WAIT_L
#undef PG8_BAR
#undef PG8_SCHED
}
}

struct FGU { const float* wg; const float* wu; DI float operator()(int n, int k) const { const int pn = n >> 8, j = n & 255; const long d = (j < 128) ? 0 : (wu - wg); return __builtin_nontemporal_load(&wg[(long)k * DFF + pn * 128 + (j & 127) + d]); } };
struct FPlain { const float* w; int N; DI float operator()(int n, int k) const { return __builtin_nontemporal_load(&w[(size_t)k * N + n]); } };
DI int win_src_col(int d) {
    if (d >= DIN) return -1;
    if (d >= PC_GATE) return 1568 + (d - PC_GATE);
    if (d >= PC_SBQ) return d + 18;
    if (d < PC_KR) return d;
    if (d < PC_NQ) return PC_KR + perm32(d - PC_KR);
    const int e = d - PC_NQ, hd = e >> 6, p = e & 63;
    const bool roped = hd < 8 || hd == 10 || hd == 11 || hd == 14 || hd == 15;
    return PC_NQ + hd * 64 + (roped ? perm64(p) : p);
}
struct FWin { const float* w; DI float operator()(int n, int k) const { const int c = win_src_col(n); return c < 0 ? 0.f : __builtin_nontemporal_load(&w[(size_t)k * DIN + c]); } };
struct FUq { const float* w; DI float operator()(int n, int k) const { if (n >= 576) return 0.f; const int h = n / 96, j = n % 96; const int c = h * 96 + (j < 64 ? j : 64 + perm32(j - 64)); return __builtin_nontemporal_load(&w[(size_t)k * 576 + c]); } };
struct FUkv { const float* w; DI float operator()(int n, int k) const { int c; if (n < 384) c = (n >> 6) * 128 + (n & 63); else c = ((n - 384) >> 6) * 128 + 64 + (n & 63); return __builtin_nontemporal_load(&w[(size_t)k * 768 + c]); } };
struct FC1 { const float* wk; const float* wv; DI float operator()(int n, int k) const { const int t = k >> 6, d = k & 63; const long off = (n < 128) ? (long)(t * 64 + perm64(d)) * 128 + n : (long)k * 128 + (n - 128) + (wv - wk); return wk[off]; } };
struct FC2 { const float* wk; const float* wv; DI float operator()(int n, int k) const {
    const bool isk = n < 64 && k < 128, isv = n >= 64 && n < 128 && k >= 128;
    const long off = isk ? (long)(k * 64 + perm64(n & 63)) : isv ? (long)((k - 128) * 64 + (n - 64)) + (wv - wk) : 0;
    const float v = wk[off]; return (isk || isv) ? v : 0.f; } };

template <class F>
DI void conv_matrix(const F& f, int K, int Nd, bf16_t* dst, LAS float* scr, int gw, int NGW, int lane) {
    const int nblk = Nd / 32, items = (K / 64) * nblk;
    for (int it = gw; it < items; it += NGW) {
        const int kb = it / nblk, nb = it % nblk, k0 = 64 * kb, n0 = 32 * nb;
float tmp_[32];
#pragma unroll
        for (int i = 0; i < 32; ++i) tmp_[i] = f(n0 + (lane & 31), k0 + 2 * i + (lane >> 5));
#pragma unroll
        for (int i = 0; i < 32; ++i) scr[(2 * i + (lane >> 5)) * 33 + (lane & 31)] = tmp_[i];
        asm volatile("s_waitcnt lgkmcnt(0)" ::: "memory");
        const int c = lane & 7;
#pragma unroll
        for (int j = 0; j < 4; ++j) { const int n = (lane >> 3) + 8 * j; const LAS float* s = scr + (8 * c) * 33 + n;
            u32x4 o; o.x = cvtpk(s[0 * 33], s[1 * 33]); o.y = cvtpk(s[2 * 33], s[3 * 33]); o.z = cvtpk(s[4 * 33], s[5 * 33]); o.w = cvtpk(s[6 * 33], s[7 * 33]);
            *(u32x4*)(dst + (size_t)(n0 + n) * K + k0 + 8 * c) = o; }
        asm volatile("s_waitcnt lgkmcnt(0)" ::: "memory");
    }
}

DI int crow(int r, int hi) { return (r & 3) + 8 * (r >> 2) + 4 * hi; }
#define MFMA32(a, b, c) __builtin_amdgcn_mfma_f32_32x32x16_bf16((a), (b), (c), 0, 0, 0)
DI bf16x8 pack8(const f32x16& x, int s) {
    u32x4 p; p.x = cvtpk(x[8 * s], x[8 * s + 1]); p.y = cvtpk(x[8 * s + 2], x[8 * s + 3]); p.z = cvtpk(x[8 * s + 4], x[8 * s + 5]); p.w = cvtpk(x[8 * s + 6], x[8 * s + 7]);
    return __builtin_bit_cast(bf16x8, p);
}
typedef short v4i16_t __attribute__((ext_vector_type(4)));
DI s16x4 vtr(const LAS unsigned char* p) { return __builtin_bit_cast(s16x4, __builtin_amdgcn_ds_read_tr16_b64_v4i16((LAS v4i16_t*)p)); }
constexpr int VP2 = 144;
constexpr int AT_K = 0, AT_V = 28672, AT_MISC = 49152;
DI bf16x8 vfrag(const LAS unsigned char* Vs, int lane, int d0, int kb, int s) {
    const int i16 = lane & 15, g = lane >> 4, blk = g & 1, hi = g >> 1;
    const LAS unsigned char* p = Vs + (32 * kb + 16 * s + 4 * hi + (i16 >> 2)) * VP2 + 64 * d0 + 32 * blk + 8 * (i16 & 3);
    const s16x4 lo = vtr(p), hh = vtr(p + 8 * VP2);
    return (bf16x8){lo[0], lo[1], lo[2], lo[3], hh[0], hh[1], hh[2], hh[3]};
}
DI void store_o(const f32x16 (&o)[2], bf16_t* dst_row, int hi) {
#pragma unroll
    for (int d0 = 0; d0 < 2; ++d0)
#pragma unroll
        for (int jp = 0; jp < 4; jp += 2) {
            const unsigned a0 = cvtpk(o[d0][4 * jp], o[d0][4 * jp + 1]), a1 = cvtpk(o[d0][4 * jp + 2], o[d0][4 * jp + 3]);
            const unsigned b0 = cvtpk(o[d0][4 * jp + 4], o[d0][4 * jp + 5]), b1 = cvtpk(o[d0][4 * jp + 6], o[d0][4 * jp + 7]);
            const auto r0 = __builtin_amdgcn_permlane32_swap(a0, b0, false, false);
            const auto r1 = __builtin_amdgcn_permlane32_swap(a1, b1, false, false);
            const u32x4 w = {r0[0], r1[0], r0[1], r1[1]};
            *(u32x4*)(dst_row + 32 * d0 + 8 * (jp + hi)) = w;
        }
}

enum { MODE_CAUSAL = 0, MODE_CMP = 1, MODE_SEL = 2, MODE_WIN = 3 };
template <int DQK, int MODE>
DI void flash_unit(LAS unsigned char* lds, int wv0, const bf16_t* Qp, int qpitch, const bf16_t* K1, int k1pitch, const bf16_t* K2, int k2pitch,
                   const bf16_t* Vp, int vpitch, int q0, int t0, int t1, float sc, u32x4 mw, float gate, f32x16 (&tot)[2], float* lse_out, const float* rope = nullptr) {
    constexpr int KP2 = (DQK + 8) * 2, NKS = DQK / 16, KBUF = 64 * KP2, VBUF = 64 * VP2;
    const int tid = fresh_tid2(wv0), lane = tid & 63, wid = wv0, r32 = lane & 31, hi = lane >> 5;
    const int qpos = q0 + 32 * wid + r32, qmin = q0 + 32 * wid, qmax = qmin + 31;
    bf16x8 qf[NKS];
#pragma unroll
    for (int ks = 0; ks < NKS; ++ks) qf[ks] = *(const bf16x8*)(Qp + (size_t)(32 * wid + r32) * qpitch + 16 * ks + 8 * hi);
    if (DQK == 96) {
#pragma unroll
        for (int ks = 4; ks < NKS; ++ks) {
            const int p0 = 8 * (ks - 4) + 4 * hi;
            const f32x4 c4 = *(const f32x4*)(rope + ROPE_MLA_COS + qpos * 16 + p0), s4 = *(const f32x4*)(rope + ROPE_MLA_SIN + qpos * 16 + p0);
            u32x4 w = __builtin_bit_cast(u32x4, qf[ks]);
#pragma unroll
            for (int k = 0; k < 4; ++k) { const float x1 = bflo(w[k]), x2 = bfhi(w[k]); w[k] = cvtpk(x1 * c4[k] - x2 * s4[k], x2 * c4[k] + x1 * s4[k]); }
            qf[ks] = __builtin_bit_cast(bf16x8, w);
        }
    }
#pragma unroll
    for (int ks = 0; ks < NKS; ++ks) asm volatile("" : "+v"(qf[ks]));
    f32x16 o[2]; o[0] = (f32x16){}; o[1] = (f32x16){};
    float mref = -1e30f, l = 0.f;
    const int srow = tid >> 3, sch = tid & 7, srow2 = tid >> 2, sch2 = tid & 3;
    u32x4 rk1, rk2 = (u32x4){}, rv;
#define FL_GLOAD(t) do { const unsigned kv_ = 64u * (unsigned)(t); \
        rk1 = *(const u32x4*)((const char*)K1 + (unsigned)(((kv_ + (unsigned)srow) * (unsigned)k1pitch + (unsigned)sch * 8u) * 2u)); \
        if (DQK == 96 && tid < 256) rk2 = *(const u32x4*)((const char*)K2 + (unsigned)(((kv_ + (unsigned)srow2) * (unsigned)k2pitch + (unsigned)sch2 * 8u) * 2u)); \
        rv = *(const u32x4*)((const char*)Vp + (unsigned)(((kv_ + (unsigned)srow) * (unsigned)vpitch + (unsigned)sch * 8u) * 2u)); } while (0)
#define FL_LSTORE(buf) do { *(LAS u32x4*)(lds + AT_K + (buf) * KBUF + srow * KP2 + sch * 16) = rk1; \
        if (DQK == 96 && tid < 256) *(LAS u32x4*)(lds + AT_K + (buf) * KBUF + srow2 * KP2 + 128 + sch2 * 16) = rk2; \
        *(LAS u32x4*)(lds + AT_V + (buf) * VBUF + srow * VP2 + sch * 16) = rv; } while (0)
    FL_GLOAD(t0);
    __syncthreads();
    FL_LSTORE(0);
    if (t0 + 1 < t1) FL_GLOAD(t0 + 1);
    __syncthreads();
    for (int t = t0; t < t1; ++t) {
        const int cur = (t - t0) & 1;
        const LAS unsigned char* Ks = lds + AT_K + cur * KBUF; const LAS unsigned char* Vs = lds + AT_V + cur * VBUF;
        bool active = true;
        if (MODE == MODE_CAUSAL || MODE == MODE_SEL || MODE == MODE_WIN) active = (64 * t <= qmax);
        if (MODE == MODE_WIN) active = active && (64 * t + 63 + 512 > qmin);
        if (MODE == MODE_CMP) active = (16 * (64 * t) + 31 <= qmax);
        if (active) {
            f32x16 s[2];
            bf16x8 ka[2][NKS]; s16x4 vlo[2][2][2], vhi[2][2][2];
            {
                const unsigned kaddr = (unsigned)(unsigned long)(lds + AT_K + cur * KBUF) + (unsigned)(r32 * KP2 + hi * 16);
                const unsigned vaddr = (unsigned)(unsigned long)(lds + AT_V + cur * VBUF) + (unsigned)((4 * hi + ((lane & 15) >> 2)) * VP2 + 32 * ((lane >> 4) & 1) + 8 * (lane & 3));
#pragma unroll
                for (int kb = 0; kb < 2; ++kb)
#pragma unroll
                    for (int ks = 0; ks < NKS; ++ks) asm volatile("ds_read_b128 %0, %1 offset:%2" : "=v"(ka[kb][ks]) : "v"(kaddr), "n"(kb * 32 * KP2 + ks * 32) : "memory");
#pragma unroll
                for (int s2 = 0; s2 < 2; ++s2)
#pragma unroll
                    for (int d0 = 0; d0 < 2; ++d0) {
                        asm volatile("ds_read_b64_tr_b16 %0, %1 offset:%2" : "=v"(vlo[0][s2][d0]) : "v"(vaddr), "n"(16 * s2 * VP2 + 64 * d0) : "memory");
                        asm volatile("ds_read_b64_tr_b16 %0, %1 offset:%2" : "=v"(vhi[0][s2][d0]) : "v"(vaddr), "n"(16 * s2 * VP2 + 64 * d0 + 8 * VP2) : "memory");
                    }
                asm volatile("s_waitcnt lgkmcnt(8)" ::: "memory");
#pragma unroll
                for (int kb = 0; kb < 2; ++kb)
#pragma unroll
                    for (int ks = 0; ks < NKS; ++ks) asm volatile("" : "+v"(ka[kb][ks]));
                s[0] = (f32x16){}; s[1] = (f32x16){};
                __builtin_amdgcn_s_setprio(1);
#pragma unroll
                for (int ks = 0; ks < NKS; ++ks) { s[0] = MFMA32(ka[0][ks], qf[ks], s[0]); s[1] = MFMA32(ka[1][ks], qf[ks], s[1]); }
                __builtin_amdgcn_s_setprio(0);
#pragma unroll
                for (int s2 = 0; s2 < 2; ++s2)
#pragma unroll
                    for (int d0 = 0; d0 < 2; ++d0) {
                        asm volatile("ds_read_b64_tr_b16 %0, %1 offset:%2" : "=v"(vlo[1][s2][d0]) : "v"(vaddr), "n"((32 + 16 * s2) * VP2 + 64 * d0) : "memory");
                        asm volatile("ds_read_b64_tr_b16 %0, %1 offset:%2" : "=v"(vhi[1][s2][d0]) : "v"(vaddr), "n"((32 + 16 * s2) * VP2 + 64 * d0 + 8 * VP2) : "memory");
                    }
            }
            bool need_mask;
            if (MODE == MODE_CMP) need_mask = true;
            else if (MODE == MODE_WIN) need_mask = (64 * t + 63 > qmin) || (64 * t + 512 <= qmax);
            else need_mask = (64 * t + 63 > qmin);
            if (need_mask) {
#pragma unroll
                for (int kb = 0; kb < 2; ++kb)
#pragma unroll
                    for (int i = 0; i < 16; ++i) {
                        const int kv = 64 * t + 32 * kb + crow(i, hi);
                        bool valid;
                        if (MODE == MODE_CMP) valid = (16 * kv + 31 <= qpos);
                        else if (MODE == MODE_WIN) valid = (kv <= qpos) && (kv + 512 > qpos);
                        else valid = kv <= qpos;
                        s[kb][i] = valid ? s[kb][i] : -INFINITY;
                    }
            }
            if (MODE == MODE_SEL) {
                const unsigned w = (t < 32) ? mw.x : (t < 64) ? mw.y : (t < 96) ? mw.z : mw.w; const bool selw = ((w >> (t & 31)) & 1u) != 0;
                if (!__all(selw)) {
#pragma unroll
                    for (int kb = 0; kb < 2; ++kb)
#pragma unroll
                        for (int i = 0; i < 16; ++i) s[kb][i] = selw ? s[kb][i] : -INFINITY;
                }
            }
            float mx = fmaxf(s[0][0], s[1][0]);
#pragma unroll
            for (int i = 1; i < 16; ++i) mx = fmaxf(fmaxf(mx, s[0][i]), s[1][i]);
            mx = half_max(mx);
            const float msc = mx * sc;
            if (__any(msc > mref + 8.f)) {
                const float mnew = fmaxf(mref, msc), alpha = __builtin_amdgcn_exp2f(mref - mnew);
                mref = mnew; l *= alpha;
#pragma unroll
                for (int i = 0; i < 16; ++i) { o[0][i] *= alpha; o[1][i] *= alpha; }
            }
            float ls = 0.f;
#pragma unroll
            for (int kb = 0; kb < 2; ++kb)
#pragma unroll
                for (int i = 0; i < 16; ++i) { const float p = __builtin_amdgcn_exp2f(__builtin_fmaf(s[kb][i], sc, -mref)); s[kb][i] = p; ls += p; }
            l += ls;
            {
                asm volatile("s_waitcnt lgkmcnt(0)" ::: "memory");
#pragma unroll
                for (int kb = 0; kb < 2; ++kb)
#pragma unroll
                    for (int s2 = 0; s2 < 2; ++s2)
#pragma unroll
                        for (int d0 = 0; d0 < 2; ++d0) { asm volatile("" : "+v"(vlo[kb][s2][d0]), "+v"(vhi[kb][s2][d0])); }
                __builtin_amdgcn_s_setprio(1);
#pragma unroll
                for (int kb = 0; kb < 2; ++kb)
#pragma unroll
                    for (int s2 = 0; s2 < 2; ++s2) {
                        const bf16x8 pf = pack8(s[kb], s2);
#pragma unroll
                        for (int d0 = 0; d0 < 2; ++d0) {
                            const s16x4 lo = vlo[kb][s2][d0], hh = vhi[kb][s2][d0];
                            const bf16x8 vfr = (bf16x8){lo[0], lo[1], lo[2], lo[3], hh[0], hh[1], hh[2], hh[3]};
                            o[d0] = MFMA32(vfr, pf, o[d0]);
                        }
                    }
                __builtin_amdgcn_s_setprio(0);
            }
        }
        if (t + 1 < t1) { FL_LSTORE(cur ^ 1); if (t + 2 < t1) FL_GLOAD(t + 2); }
        __syncthreads();
    }
#undef FL_GLOAD
#undef FL_LSTORE
    const float lt = half_sum(l);
    bool rowok = true;
    if (MODE == MODE_CMP) rowok = qpos >= 31;
    const float inv = (rowok && lt > 0.f) ? gate / lt : 0.f;
#pragma unroll
    for (int i = 0; i < 16; ++i) { tot[0][i] += o[0][i] * inv; tot[1][i] += o[1][i] * inv; }
    if (MODE == MODE_CMP && hi == 0) lse_out[32 * wid + r32] = rowok ? (mref + __builtin_amdgcn_logf(lt)) : INFINITY;
}

DI void sb_unit(LAS unsigned char* lds, int wv0, const bf16_t* Qp, const bf16_t* Kp, const bf16_t* Vp, int q0, f32x16 (&o)[2]) {
    constexpr int KP2 = 144, pitch = NPROJ;
    const int tid = fresh_tid2(wv0), lane = tid & 63, wid = wv0, r32 = lane & 31, hi = lane >> 5;
    const int qpos = q0 + 32 * wid + r32, qmax = q0 + 32 * wid + 31;
    LAS unsigned char* Ks = lds + AT_K; LAS unsigned char* Vs = lds + AT_V; volatile LAS int* flags = (volatile LAS int*)(lds + AT_MISC);
    bf16x8 qf[4];
#pragma unroll
    for (int ks = 0; ks < 4; ++ks) qf[ks] = *(const bf16x8*)(Qp + (size_t)(32 * wid + r32) * pitch + 16 * ks + 8 * hi);
#pragma unroll
    for (int ks = 0; ks < 4; ++ks) asm volatile("" : "+v"(qf[ks]));
    float R = 0.f; bool wdone = false;
    const int srow = tid >> 3, sch = tid & 7;
    u32x4 rk, rv;
    const int tlast = (q0 + 255) >> 6;
    auto gload = [&](int t) { const size_t kv = (size_t)64 * t; rk = *(const u32x4*)(Kp + (kv + srow) * pitch + sch * 8); rv = *(const u32x4*)(Vp + (kv + srow) * pitch + sch * 8); };
    gload(tlast);
    if (lane == 0) flags[wid] = 0;
    for (int t = tlast; t >= 0; --t) {
        __syncthreads();
        { int alld = 1;
#pragma unroll
          for (int w = 0; w < 8; ++w) alld &= flags[w];
          if (alld) break; }
        *(LAS u32x4*)(Ks + srow * KP2 + sch * 16) = rk;
        *(LAS u32x4*)(Vs + srow * VP2 + sch * 16) = rv;
        __syncthreads();
        if (t > 0) gload(t - 1);
        const bool active = (64 * t < qmax) && !wdone;
        if (!active) continue;
        f32x16 s[2];
#pragma unroll
        for (int kb = 0; kb < 2; ++kb) {
            s[kb] = (f32x16){};
#pragma unroll
            for (int ks = 0; ks < 4; ++ks) { const bf16x8 a = *(const LAS bf16x8*)(Ks + (32 * kb + r32) * KP2 + ks * 32 + hi * 16); s[kb] = MFMA32(a, qf[ks], s[kb]); }
        }
        f32x16 lr[2];
        float own[8];
#pragma unroll
        for (int kb = 0; kb < 2; ++kb)
#pragma unroll
            for (int i = 0; i < 16; ++i) {
                const int kv = 64 * t + 32 * kb + crow(i, hi);
                const float z = s[kb][i] * 0.125f;
                const float sp = fmaxf(z, 0.f) + __logf(1.f + __expf(-fabsf(z)));
                const bool strict = kv < qpos;
                lr[kb][i] = strict ? -sp : 0.f;
                s[kb][i] = strict ? (z - sp) : -1e30f;
            }
#pragma unroll
        for (int g = 0; g < 8; ++g) { const int kb = g >> 2, j = g & 3; own[g] = (lr[kb][4 * j] + lr[kb][4 * j + 1]) + (lr[kb][4 * j + 2] + lr[kb][4 * j + 3]); }
        float E[8], Od[8], T[8];
#pragma unroll
        for (int g = 0; g < 8; ++g) { const float oth = half_other(own[g], hi); E[g] = hi ? oth : own[g]; Od[g] = hi ? own[g] : oth; }
        T[7] = 0.f;
#pragma unroll
        for (int g = 6; g >= 0; --g) T[g] = T[g + 1] + (E[g + 1] + Od[g + 1]);
        const float tile_tot = T[0] + (E[0] + Od[0]);
#pragma unroll
        for (int g = 0; g < 8; ++g) {
            const int kb = g >> 2, j = g & 3;
            const float sg = (hi ? T[g] : T[g] + Od[g]) + R;
            const float l3 = lr[kb][4 * j + 3], l2 = lr[kb][4 * j + 2], l1 = lr[kb][4 * j + 1];
            const float su3 = sg, su2 = sg + l3, su1 = su2 + l2, su0 = su1 + l1;
            s[kb][4 * j + 3] = __builtin_amdgcn_exp2f((s[kb][4 * j + 3] + su3) * LOG2E);
            s[kb][4 * j + 2] = __builtin_amdgcn_exp2f((s[kb][4 * j + 2] + su2) * LOG2E);
            s[kb][4 * j + 1] = __builtin_amdgcn_exp2f((s[kb][4 * j + 1] + su1) * LOG2E);
            s[kb][4 * j + 0] = __builtin_amdgcn_exp2f((s[kb][4 * j + 0] + su0) * LOG2E);
        }
        R += tile_tot;
#pragma unroll
        for (int kb = 0; kb < 2; ++kb)
#pragma unroll
            for (int s2 = 0; s2 < 2; ++s2) {
                const bf16x8 pf = pack8(s[kb], s2);
#pragma unroll
                for (int d0 = 0; d0 < 2; ++d0) { const bf16x8 vf = vfrag(Vs, lane, d0, kb, s2); o[d0] = MFMA32(vf, pf, o[d0]); }
            }
        if (!__any(R >= -104.f)) { wdone = true; if (lane == 0) flags[wid] = 1; }
    }
    if (lane == 0) flags[wid] = 1;
}


#define XB_TMO      128
#define XB_XCNT(j)  (256  + 64 * (j))
#define XB_XSUB(j)  (1280 + 64 * (j))
#define XB_XGEN(j)  (2304 + 64 * (j))
#define XB_TOP      3328
#define XB_TOPGEN   3392
#define XCD_BAR_WORDS 3456
#define XB_SPIN_CAP (1u << 18)
DI unsigned xb_ld(unsigned* p)              { return __hip_atomic_load(p, __ATOMIC_RELAXED, __HIP_MEMORY_SCOPE_AGENT); }
DI unsigned xb_add(unsigned* p, unsigned v) { return __hip_atomic_fetch_add(p, v, __ATOMIC_RELAXED, __HIP_MEMORY_SCOPE_AGENT); }
DI unsigned xb_xcc_id() { return (unsigned)__builtin_amdgcn_s_getreg((3 << 11) | 20) & 0xFu; }
#define XB_SPIN(cond, bar) do { unsigned _sp = 0; while (cond) { __builtin_amdgcn_s_sleep(1); \
    if ((++_sp & 255u) == 0u) { if (xb_ld(&(bar)[XB_TMO])) break; if (_sp > XB_SPIN_CAP) { atomicAdd(&(bar)[XB_TMO], 1u); break; } } } } while (0)
struct XcdBarrier { unsigned* bar; unsigned x; volatile LAS unsigned* st; };
DI void xcd_barrier_complete(unsigned* bar, unsigned x, unsigned& nloc, unsigned& nx) {
    const unsigned G = gridDim.x * gridDim.y * gridDim.z;
    unsigned sum, cnt, mine, sp = 0u;
    for (;;) {
        sum = 0u; cnt = 0u; mine = 0u;
#pragma unroll
        for (unsigned j = 0; j < 16; ++j) { const unsigned c = xb_ld(&bar[XB_XCNT(j)]); sum += c; cnt += (c > 0u) ? 1u : 0u; mine = (j == x) ? c : mine; }
        if (sum == G) break;
        __builtin_amdgcn_s_sleep(1);
        if ((++sp & 255u) == 0u) { if (xb_ld(&bar[XB_TMO])) break; if (sp > XB_SPIN_CAP) { atomicAdd(&bar[XB_TMO], 1u); break; } }
    }
    nloc = mine > 0u ? mine : 1u; nx = cnt > 0u ? cnt : 1u;
}
DI void xcd_barrier(const XcdBarrier& b) {
    asm volatile("s_waitcnt vmcnt(0)" ::: "memory");
    __syncthreads();
    if (threadIdx.x == 0) {
        unsigned* bar = b.bar;
        __builtin_amdgcn_s_waitcnt(0);
        unsigned nloc = b.st[0], nx = b.st[1];
        if (nloc == 0u) { xcd_barrier_complete(bar, b.x, nloc, nx); b.st[0] = nloc; b.st[1] = nx; }
        const unsigned old = xb_add(&bar[XB_XSUB(b.x)], 1u);
        const unsigned gen = old / nloc;
        if (old + 1u == (gen + 1u) * nloc) {
            __builtin_amdgcn_fence(__ATOMIC_RELEASE, "agent");
            asm volatile("s_waitcnt vmcnt(0)" ::: "memory");
            const unsigned og = xb_add(&bar[XB_TOP], 1u);
            const unsigned tg = og / nx;
            if (og + 1u == (tg + 1u) * nx) xb_add(&bar[XB_TOPGEN], 1u);
            else XB_SPIN(xb_ld(&bar[XB_TOPGEN]) == tg, bar);
            __builtin_amdgcn_fence(__ATOMIC_ACQUIRE, "agent");
            xb_add(&bar[XB_XGEN(b.x)], 1u);
            asm volatile("s_waitcnt vmcnt(0)" ::: "memory");
        } else {
            XB_SPIN(xb_ld(&bar[XB_XGEN(b.x)]) == gen, bar);
            __builtin_amdgcn_fence(__ATOMIC_ACQUIRE, "agent");
            asm volatile("s_waitcnt vmcnt(0)" ::: "memory");
        }
    }
    __syncthreads();
}
constexpr int BAR_WORD0 = 4096;
constexpr int LDS_BARST = 131072 + 32;

DI const float* gptr(LAS unsigned char* lds, int i);
DI void gsync(LAS unsigned char* lds) {
    XcdBarrier b; b.bar = (unsigned*)gptr(lds, 25) + BAR_WORD0; b.x = xb_xcc_id(); b.st = (volatile LAS unsigned*)(lds + LDS_BARST);
    xcd_barrier(b);
}
DI void gsync_cg(cg::grid_group& grid) {
    asm volatile("s_waitcnt vmcnt(0) lgkmcnt(0)" ::: "memory");
    grid.sync();
    __builtin_amdgcn_fence(__ATOMIC_ACQUIRE, "agent");
    asm volatile("s_waitcnt vmcnt(0)" ::: "memory");
}
DI void norm_rows(const float* src, const float* gain, bf16_t* HN, int gw, int NGW, int lane) {
    for (int mrow_ = gw; mrow_ < MTOK * REP_NORM; mrow_ += NGW) {
        const int mrow = mrow_ & (MTOK - 1);
        const f32x4* xr = (const f32x4*)(src + (size_t)mrow * DM) + lane;
        f32x4 v[4]; float ss = 0.f;
#pragma unroll
        for (int j = 0; j < 4; ++j) { v[j] = xr[64 * j]; ss += (v[j].x * v[j].x + v[j].y * v[j].y) + (v[j].z * v[j].z + v[j].w * v[j].w); }
        const float r = rsqrtf(wave_sum(ss) * (1.f / DM) + EPS);
        u32x2* o8 = (u32x2*)(HN + (size_t)mrow * DM) + lane;
#pragma unroll
        for (int j = 0; j < 4; ++j) { const f32x4 gg = ((const f32x4*)gain)[lane + 64 * j]; u32x2 w; w.x = cvtpk(v[j].x * r * gg.x, v[j].y * r * gg.y); w.y = cvtpk(v[j].z * r * gg.z, v[j].w * r * gg.w); o8[64 * j] = w; }
    }
}
DI void conv_ffn(const float* wg, const float* wu, const float* wd, bf16_t* Wgu, bf16_t* Wd, LAS float* scr, int gw, int NGW, int lane) {
    conv_matrix(FGU{wg, wu}, DM, 2 * DFF, Wgu, scr, gw, NGW, lane);
    conv_matrix(FPlain{wd, DM}, DFF, DM, Wd, scr, gw, NGW, lane);
}
DI void ffn_gemms(LAS unsigned char* lds, cg::grid_group& grid, unsigned char* ws, const float* base, float* X, int G, int bid, int wv0) {
    bf16_t* Wgu = (bf16_t*)(ws + WS_WGU); bf16_t* Wd = (bf16_t*)(ws + WS_WD); bf16_t* HN = (bf16_t*)(ws + WS_HN); bf16_t* ACT = (bf16_t*)(ws + WS_R);
    for (int rep = 0; rep < REP_FFN; ++rep) {
    { pg8::Gemm g{HN, Wgu, MTOK, 2 * DFF, DM, DM, DM}; pg8::StaticOrder S; S.init(MTOK, 2 * DFF, G, bid); pg8::EpiSwiGLU E{ACT, DFF}; pg8::gemm_phase(lds, g, S, E, wv0); }
    gsync(lds);
    { pg8::Gemm g{ACT, Wd, MTOK, DM, DFF, DFF, DFF}; pg8::StaticOrder S; S.init(MTOK, DM, G, bid); pg8::EpiResid E{rep == 0 ? base : X, X, DM, rep == 0 ? 0.5f : 0.f}; pg8::gemm_phase(lds, g, S, E, wv0); }
    gsync(lds);
    }
}

struct Params {
    const float* in[24];
    float* out;
    unsigned char* ws;
};

DI const float* gptr(LAS unsigned char* lds, int i) {
    LAS unsigned char* b = lds + PTAB; asm volatile("" : "+v"(b));
    volatile LAS unsigned* p = (volatile LAS unsigned*)(b + 8 * i);
    const unsigned lo = __builtin_amdgcn_readfirstlane(p[0]), hi = __builtin_amdgcn_readfirstlane(p[1]);
    return (const float*)(((unsigned long long)hi << 32) | lo);
}
#define PIN(i) gptr(lds, (i))
#define GET_WS() ((unsigned char*)gptr(lds, 25))
#define GET_X() ((float*)gptr(lds, 24))
#define WSP(type, off) ((type*)(ws + (off)))
#define Wgu WSP(bf16_t, WS_WGU)
#define Wd WSP(bf16_t, WS_WD)
#define Win WSP(bf16_t, WS_WIN)
#define Wout WSP(bf16_t, WS_WOUT)
#define Wc1 WSP(bf16_t, WS_WC1)
#define Wuq WSP(bf16_t, WS_WUQ)
#define Wukv WSP(bf16_t, WS_WUKV)
#define Wc2 WSP(bf16_t, WS_WC2)
#define HN WSP(bf16_t, WS_HN)
#define ACT WSP(bf16_t, WS_R)
#define PROJ WSP(bf16_t, WS_R)
#define GATES WSP(float, WS_GATES)
#define MASKS WSP(unsigned, WS_MASK)
#define LSE WSP(float, WS_LSE)
#define HID WSP(bf16_t, WS_HID)
#define KCVC WSP(bf16_t, WS_KCVC)
#define QMLA WSP(bf16_t, WS_QMLA)
#define KVB WSP(bf16_t, WS_KVB)
#define OCMP WSP(bf16_t, WS_OCMP)
#define FLAT WSP(bf16_t, WS_FLAT)
#define S1 WSP(float, WS_S1)
#define S2 WSP(float, WS_S2)
#define PHASE_PTRS unsigned char* ws = GET_WS(); float* X = GET_X(); (void)ws; (void)X; const int G = fresh_s(G0), bid = fresh_s(bid0), NGW = G * 8; (void)NGW; const int tid = fresh_tid2(wv0), lane = tid & 63, wid = wv0, gw = bid * 8 + wid; (void)lane; (void)gw; \
    LAS float* scr = (LAS float*)(lds + wid * 8704); (void)scr; volatile LAS int* s_item = (volatile LAS int*)(lds + 131072); (void)s_item

__global__ void __launch_bounds__(512) mega_fwd(Params P) {
    extern __shared__ __attribute__((aligned(16))) unsigned char lds_raw[];
    LAS unsigned char* const lds0 = (LAS unsigned char*)lds_raw;
#define lds fresh_lds(lds0)
    cg::grid_group grid = cg::this_grid();
    { const int tid = threadIdx.x;
    if (tid < 24) *(LAS unsigned long long*)(lds + PTAB + 8 * tid) = (unsigned long long)P.in[tid];
    if (tid == 24) *(LAS unsigned long long*)(lds + PTAB + 8 * 24) = (unsigned long long)P.out;
    if (tid == 25) *(LAS unsigned long long*)(lds + PTAB + 8 * 25) = (unsigned long long)P.ws;
    if (tid == 26) { *(LAS unsigned*)(lds + LDS_BARST) = 0u; *(LAS unsigned*)(lds + LDS_BARST + 4) = 0u; }
    if (tid == 0) (void)xb_add((unsigned*)P.ws + BAR_WORD0 + XB_XCNT(xb_xcc_id()), 1u); }
    __syncthreads();
    gsync_cg(grid);
    const int G0 = gridDim.x, bid0 = blockIdx.x;
    int wv0 = __builtin_amdgcn_readfirstlane((int)threadIdx.x >> 6); asm volatile("" : "+s"(wv0));

    for (int L = 0; L < 2; ++L) {
        { PHASE_PTRS; const float* xin = (L == 0) ? PIN(0) : X;
        norm_rows(xin, PIN(1) + L * DM, HN, gw, NGW, lane);
        if (L == 0) {
            float* rt = WSP(float, WS_ROPE);
            for (int idx = gw * 64 + lane; idx < 8192 * 16; idx += NGW * 64) { const int pos = idx >> 4, i = idx & 15; float c, sn; rope_cs(pos, inv_freq_of(i, 1.f / 16.f), c, sn); rt[ROPE_MLA_COS + idx] = c; rt[ROPE_MLA_SIN + idx] = sn; }
            for (int idx = gw * 64 + lane; idx < 8192 * 8; idx += NGW * 64) { const int pos = idx >> 3, i = idx & 7; float c, sn; rope_cs(pos, inv_freq_of(i, 1.f / 8.f), c, sn); rt[ROPE_NSA_COS + idx] = c; rt[ROPE_NSA_SIN + idx] = sn; }
        }
        for (int rep = 0; rep < REP_CONV; ++rep) {
        conv_ffn(PIN(2) + (size_t)L * DM * DFF, PIN(3) + (size_t)L * DM * DFF, PIN(4) + (size_t)L * DFF * DM, Wgu, Wd, scr, gw, NGW, lane);
        conv_matrix(FWin{PIN(6) + (size_t)L * DM * DIN}, DM, NPROJ, Win, scr, gw, NGW, lane);
        conv_matrix(FPlain{PIN(18) + (size_t)L * DM * DM, DM}, DM, DM, Wout, scr, gw, NGW, lane);
        conv_matrix(FUq{PIN(8) + (size_t)L * 256 * 576}, 256, 768, Wuq, scr, gw, NGW, lane);
        conv_matrix(FUkv{PIN(10) + (size_t)L * 128 * 768}, 128, 768, Wukv, scr, gw, NGW, lane);
        conv_matrix(FC1{PIN(13) + (size_t)L * 2048 * 128, PIN(16) + (size_t)L * 2048 * 128}, 2048, 256, Wc1, scr, gw, NGW, lane);
        conv_matrix(FC2{PIN(14) + (size_t)L * 128 * 64, PIN(17) + (size_t)L * 128 * 64}, 256, 256, Wc2, scr, gw, NGW, lane); } }
        gsync(lds);
        { PHASE_PTRS; const float* xin = (L == 0) ? PIN(0) : X; ffn_gemms(lds, grid, ws, xin, X, G, bid, wv0); }
        { PHASE_PTRS;
        norm_rows(X, PIN(5) + L * DM, HN, gw, NGW, lane);
        conv_ffn(PIN(20) + (size_t)L * DM * DFF, PIN(21) + (size_t)L * DM * DFF, PIN(22) + (size_t)L * DFF * DM, Wgu, Wd, scr, gw, NGW, lane); }
        gsync(lds);
        for (int rep = 0; rep < REP_G2; ++rep) { PHASE_PTRS; pg8::Gemm g{HN, Win, MTOK, NPROJ, DM, DM, DM}; pg8::StaticOrder S; S.init(MTOK, NPROJ, G, bid); pg8::EpiBf16<0> E{PROJ, NPROJ, NPROJ}; pg8::gemm_phase(lds, g, S, E, wv0); }
        gsync(lds);
#ifndef X_NOPOST
        { PHASE_PTRS;
            const float* qn = PIN(7) + L * 256; const float* kvn = PIN(9) + L * 128; const float* gbias = PIN(11) + L * 18;
            const float* posk = PIN(12) + L * 2048; const float* posv = PIN(15) + L * 2048; const float* rt = WSP(float, WS_ROPE);
            if (gw < 8) {
                const size_t R = (gw < 4) ? (size_t)(2044 + gw) : (size_t)(2048 + 2044 + (gw - 4));
#pragma unroll
                for (int j = 0; j < 4; ++j) *(u32x4*)(FLAT + R * 2048 + (j * 64 + lane) * 8) = (u32x4){0u, 0u, 0u, 0u};
            }
            const f32x4 gq = ((const f32x4*)qn)[lane]; const f32x2 gkv = ((const f32x2*)kvn)[lane]; const float gb = lane < 18 ? gbias[lane] : 0.f;
            const int g_ = lane >> 5, pp = lane & 31;
            const int hdA = lane >> 3, iA = lane & 7, baseA = hdA < 6 ? PC_NQ + 64 * hdA : PC_KS + 64 * (hdA - 6);
            const int hdB = 8 + (lane >> 3), baseB = PC_KW + 64 * (hdB - 8);
            for (int mrow = gw; mrow < MTOK; mrow += NGW) {
                bf16_t* pr = PROJ + (size_t)mrow * NPROJ;
                const int b = mrow >> 13, spos = mrow & (SEQ - 1);
                const int j = spos >> 4, t16 = spos & 15;
                u32x2 wcq = *(const u32x2*)(pr + PC_CQ + 4 * lane);
                const unsigned wckv = *(const unsigned*)(pr + PC_CKV + 2 * lane);
                const unsigned wkr = *(const unsigned*)(pr + PC_KR + 2 * (lane & 15));
                const float ckr = rt[ROPE_MLA_COS + spos * 16 + (lane & 15)], skr = rt[ROPE_MLA_SIN + spos * 16 + (lane & 15)];
                const unsigned wA = *(const unsigned*)(pr + baseA + 2 * iA);
                const unsigned wB = *(const unsigned*)(pr + baseB + 2 * iA);
                const float cn = rt[ROPE_NSA_COS + spos * 8 + iA], sn = rt[ROPE_NSA_SIN + spos * 8 + iA];
                const float gatev = bf2f(pr[PC_GATE + (lane < 18 ? lane : 0)]);
                const unsigned wk = *(const unsigned*)(pr + PC_KC + 64 * g_ + 2 * pp);
                const unsigned wv = *(const unsigned*)(pr + PC_VC + 64 * g_ + 2 * pp);
                const float ck = rt[ROPE_NSA_COS + spos * 8 + (pp & 7)], sk = rt[ROPE_NSA_SIN + spos * 8 + (pp & 7)];
                const float pk00 = posk[t16 * 64 + perm64(2 * pp)], pk01 = posk[t16 * 64 + perm64(2 * pp + 1)];
                const float pk10 = posk[(16 + t16) * 64 + perm64(2 * pp)], pk11 = posk[(16 + t16) * 64 + perm64(2 * pp + 1)];
                const f32x2 pv0 = *(const f32x2*)(posv + t16 * 64 + 2 * pp), pv1 = *(const f32x2*)(posv + (16 + t16) * 64 + 2 * pp);
                { const float a0 = bflo(wcq.x), a1 = bfhi(wcq.x), a2 = bflo(wcq.y), a3 = bfhi(wcq.y);
                  const float b0 = bflo(wckv), b1 = bfhi(wckv);
                  const float r = rsqrtf(wave_sum((a0 * a0 + a1 * a1) + (a2 * a2 + a3 * a3)) * (1.f / 256.f) + EPS);
                  const float r2 = rsqrtf(wave_sum(b0 * b0 + b1 * b1) * (1.f / 128.f) + EPS);
                  wcq.x = cvtpk(a0 * r * gq.x, a1 * r * gq.y); wcq.y = cvtpk(a2 * r * gq.z, a3 * r * gq.w);
                  *(u32x2*)(pr + PC_CQ + 4 * lane) = wcq;
                  *(unsigned*)(pr + PC_CKV + 2 * lane) = cvtpk(b0 * r2 * gkv.x, b1 * r2 * gkv.y); }
                if (lane < 16) { const float x1 = bflo(wkr), x2 = bfhi(wkr); *(unsigned*)(pr + PC_KR + 2 * lane) = cvtpk(x1 * ckr - x2 * skr, x2 * ckr + x1 * skr); }
                { const float x1 = bflo(wA), x2 = bfhi(wA); *(unsigned*)(pr + baseA + 2 * iA) = cvtpk(x1 * cn - x2 * sn, x2 * cn + x1 * sn); }
                if (lane < 16) { const float x1 = bflo(wB), x2 = bfhi(wB); *(unsigned*)(pr + baseB + 2 * iA) = cvtpk(x1 * cn - x2 * sn, x2 * cn + x1 * sn); }
                if (lane < 18) GATES[(size_t)mrow * 32 + lane] = 1.f / (1.f + __expf(-(gatev + gb)));
                {
                    float k0 = bflo(wk), k1 = bfhi(wk);
                    if (pp < 8) { const float x1 = k0, x2 = k1; k0 = x1 * ck - x2 * sk; k1 = x2 * ck + x1 * sk; }
                    const float v0 = bflo(wv), v1 = bfhi(wv);
                    if (j < NCMP) { const size_t R = (size_t)(b * NCMP + j) * 2 + g_;
                        *(unsigned*)(FLAT + R * 2048 + t16 * 64 + 2 * pp) = cvtpk(k0 + pk00, k1 + pk01);
                        *(unsigned*)(FLAT + (2048 + R) * 2048 + t16 * 64 + 2 * pp) = cvtpk(v0 + pv0.x, v1 + pv0.y); }
                    if (j >= 1) { const size_t R = (size_t)(b * NCMP + j - 1) * 2 + g_;
                        *(unsigned*)(FLAT + R * 2048 + (16 + t16) * 64 + 2 * pp) = cvtpk(k0 + pk10, k1 + pk11);
                        *(unsigned*)(FLAT + (2048 + R) * 2048 + (16 + t16) * 64 + 2 * pp) = cvtpk(v0 + pv1.x, v1 + pv1.y); }
                }
            }
        }
#endif
        gsync(lds);
        for (int rep = 0; rep < REP_G2; ++rep) {
        { PHASE_PTRS; pg8::Gemm g{PROJ + PC_CQ, Wuq, MTOK, 768, 256, NPROJ, 256}; pg8::StaticOrder S; S.init(MTOK, 768, G, bid); pg8::EpiBf16<0> E{QMLA, 576, 576}; pg8::gemm_phase(lds, g, S, E, wv0); }
        { PHASE_PTRS; pg8::Gemm g{PROJ + PC_CKV, Wukv, MTOK, 768, 128, NPROJ, 128}; pg8::StaticOrder S; S.init(MTOK, 768, G, bid); pg8::EpiBf16<0> E{KVB, 768, 768}; pg8::gemm_phase(lds, g, S, E, wv0); }
        for (int ks = 0; ks < 4; ++ks) {
            PHASE_PTRS; pg8::Gemm g{FLAT + ks * 512, Wc1 + ks * 512, 4096, 256, 512, 2048, 2048}; pg8::StaticOrder S; S.init(4096, 256, G, (bid + G - 128 - 16 * ks) % G);
            pg8::EpiF32 E{WSP(float, WS_PART) + (size_t)ks * 4096 * 256, 256}; pg8::gemm_phase(lds, g, S, E, wv0); } }
        gsync(lds);
        { PHASE_PTRS;
            const f32x4* part = (const f32x4*)WSP(float, WS_PART);
            for (int e = bid * 512 + tid; e < 4096 * 64; e += G * 512) {
                f32x4 a = part[e] + part[e + (size_t)4096 * 64] + part[e + (size_t)2 * 4096 * 64] + part[e + (size_t)3 * 4096 * 64];
#pragma unroll
                for (int i = 0; i < 4; ++i) { const float x = a[i], y = 0.7978845608028654f * (x + 0.044715f * x * x * x); a[i] = x * __builtin_amdgcn_rcpf(1.f + __expf(-2.f * y)); }
                u32x2 w; w.x = cvtpk(a[0], a[1]); w.y = cvtpk(a[2], a[3]);
                *(u32x2*)(HID + (size_t)e * 4) = w;
            }
        }
        gsync(lds);
        { PHASE_PTRS; pg8::Gemm g{HID, Wc2, 4096, 256, 256, 256, 256}; pg8::StaticOrder S; S.init(4096, 256, G, bid); pg8::EpiBf16<0> E{KCVC, 256, 256}; pg8::gemm_phase(lds, g, S, E, wv0); }
        gsync(lds);
#ifndef X_NOA1
        { PHASE_PTRS;
            unsigned* ctr = WSP(unsigned, WS_CTL) + 64 * (1 + 2 * L);
            const int r32 = lane & 31, hi = lane >> 5;
            for (;;) {
                __syncthreads();
                if (tid == 0) *s_item = (int)atomicAdd(ctr, 1u);
                __syncthreads();
                const int it = *s_item;
                if (it >= 384) break;
                const int qb = 31 - it / 12, bh = it % 12, b = bh / 6, h = bh % 6, g = h / 3, q0 = qb * 256;
                const size_t rb = (size_t)b * SEQ;
                const int cmax = (q0 + 224) >> 4, t1 = (cmax >> 6) + 1;
                const float gate = GATES[(rb + q0 + 32 * wid + r32) * 32 + h * 3 + 0];
                f32x16 tot[2]; tot[0] = (f32x16){}; tot[1] = (f32x16){};
                flash_unit<64, MODE_CMP>(lds, wv0, PROJ + (rb + q0) * NPROJ + PC_NQ + 64 * h, NPROJ, KCVC + ((size_t)(b * NCMP) * 2 + g) * 256, 512, nullptr, 0,
                                         KCVC + ((size_t)2048 + (size_t)(b * NCMP) * 2 + g) * 256 + 64, 512, q0, 0, t1, 0.125f * LOG2E, (u32x4){}, gate, tot,
                                         LSE + (size_t)(b * 6 + h) * SEQ + q0);
                store_o(tot, OCMP + (rb + q0 + 32 * wid + r32) * 384 + h * 64, hi);
            }
        }
#endif
        gsync(lds);
#ifndef X_NOA2A
        { PHASE_PTRS;
            const int r32 = lane & 31, hi = lane >> 5;
            LAS unsigned char* Ks = lds + AT_K;
            for (int it_ = bid; it_ < 256 * REP_A2; it_ += G) {
                const int thalf = it_ & 1, it = (it_ >> 1) & 127;
                const int qb = it >> 2, b = (it >> 1) & 1, g = it & 1, q0 = qb * 256;
                const size_t rb = (size_t)b * SEQ;
                const int qpos = q0 + 32 * wid + r32, qmaxw = q0 + 32 * wid + 31;
                const int cmax = (q0 + 224) >> 4, t1 = (cmax >> 6) + 1;
                bf16x8 qf[3][4]; float lse[3];
#pragma unroll
                for (int r = 0; r < 3; ++r) {
                    const int h = 3 * g + r;
#pragma unroll
                    for (int ks = 0; ks < 4; ++ks) qf[r][ks] = *(const bf16x8*)(PROJ + (rb + qpos) * NPROJ + PC_NQ + 64 * h + 16 * ks + 8 * hi);
                    lse[r] = LSE[(size_t)(b * 6 + h) * SEQ + qpos];
                }
                const bf16_t* K1 = KCVC + ((size_t)(b * NCMP) * 2 + g) * 256;
                const int srow = tid >> 3, sch = tid & 7;
                float* s1row = S1 + ((size_t)(b * 2 + g) * SEQ + qpos) * 128; float* s2row = S2 + ((size_t)(b * 2 + g) * SEQ + qpos) * 128;
                for (int t = thalf; t < t1; t += 2) {
                    __syncthreads();
                    *(LAS u32x4*)(Ks + srow * 144 + sch * 16) = *(const u32x4*)(K1 + ((size_t)64 * t + srow) * 512 + sch * 8);
                    __syncthreads();
                    if (16 * (64 * t) + 31 > qmaxw) continue;
#pragma unroll
                    for (int kb = 0; kb < 2; ++kb) {
                        f32x16 ps = (f32x16){};
#pragma unroll
                        for (int r = 0; r < 3; ++r) {
                            f32x16 s = (f32x16){};
#pragma unroll
                            for (int ks = 0; ks < 4; ++ks) { const bf16x8 a = *(const LAS bf16x8*)(Ks + (32 * kb + r32) * 144 + ks * 32 + hi * 16); s = MFMA32(a, qf[r][ks], s); }
#pragma unroll
                            for (int i = 0; i < 16; ++i) { const int c = 64 * t + 32 * kb + crow(i, hi); const bool valid = (16 * c + 31 <= qpos); ps[i] += valid ? exp2f(s[i] * (0.125f * LOG2E) - lse[r]) : 0.f; }
                        }
#pragma unroll
                        for (int j = 0; j < 4; ++j) { const int n = 16 * t + 8 * kb + 2 * j + hi; s1row[n] = (ps[4 * j] + ps[4 * j + 1]) + (ps[4 * j + 2] + ps[4 * j + 3]); s2row[n] = ps[4 * j + 3]; }
                    }
                }
            }
        }
#endif
        gsync(lds);
#ifndef X_NOA2B
        { PHASE_PTRS;
#define TK_LOAD(IT, K0, K1) do { const int q_ = (IT) & (SEQ - 1), cur_ = q_ >> 6; K0 = 0u; K1 = 0u; \
            if (cur_ > 15) { const float* s1_ = S1 + (size_t)(IT) * 128; const float* s2_ = S2 + (size_t)(IT) * 128; \
                const bool c0_ = lane >= 1 && lane <= cur_ - 2, c1_ = lane + 64 <= cur_ - 2; \
                if (c0_) K0 = __float_as_uint(s1_[lane] + s2_[lane - 1]) + 1u; \
                if (c1_) K1 = __float_as_uint(s1_[lane + 64] + s2_[lane + 63]) + 1u; } } while (0)
            const int NIT = 2 * 2 * SEQ * REP_A2;
            for (int itA_ = gw; itA_ < NIT; itA_ += 2 * NGW) {
                const int itB_ = itA_ + NGW;
                const int itA = itA_ & (2 * 2 * SEQ - 1), itB = itB_ & (2 * 2 * SEQ - 1);
                const bool hasB = itB_ < NIT;
                unsigned a0 = 0u, a1 = 0u, c0 = 0u, c1 = 0u;
                TK_LOAD(itA, a0, a1);
                if (hasB) TK_LOAD(itB, c0, c1);
                const int curA = (itA & (SEQ - 1)) >> 6, curB = (itB & (SEQ - 1)) >> 6;
                unsigned TA = 0u, TB = 0u;
                bool dA = curA <= 15, dB = !hasB || curB <= 15;
                for (int bit = 30; bit >= 0 && !(dA && dB); --bit) {
                    const unsigned trA = TA | (1u << bit), trB = TB | (1u << bit);
                    const int cA = __popcll(__ballot(a0 >= trA)) + __popcll(__ballot(a1 >= trA));
                    const int cB = __popcll(__ballot(c0 >= trB)) + __popcll(__ballot(c1 >= trB));
                    if (!dA) { if (cA == 13) { TA = trA - 1u; dA = true; } else if (cA > 13) TA = trA; }
                    if (!dB) { if (cB == 13) { TB = trB - 1u; dB = true; } else if (cB > 13) TB = trB; }
                }
#define TK_FINISH(IT, CUR, K0, K1, T) do { unsigned long long b0_ = 0ull, b1_ = 0ull; \
                    if ((CUR) <= 15) { b0_ = (2ull << (CUR)) - 1ull; } \
                    else { b0_ = __ballot((K0) > (T)); b1_ = __ballot((K1) > (T)); int need_ = 13 - __popcll(b0_) - __popcll(b1_); \
                        unsigned long long e0_ = __ballot((K0) == (T)), e1_ = __ballot((K1) == (T)); \
                        while (need_ > 0) { if (e0_) { const unsigned long long low_ = e0_ & (0ull - e0_); b0_ |= low_; e0_ ^= low_; } \
                                            else { const unsigned long long low_ = e1_ & (0ull - e1_); b1_ |= low_; e1_ ^= low_; } --need_; } \
                        b0_ |= 1ull; \
                        if ((CUR) < 64) b0_ |= 1ull << (CUR); else b1_ |= 1ull << ((CUR) - 64); \
                        if ((CUR) - 1 < 64) b0_ |= 1ull << ((CUR) - 1); else b1_ |= 1ull << ((CUR) - 65); } \
                    if (lane == 0) *(u32x4*)(MASKS + (size_t)(IT) * 4) = (u32x4){(unsigned)b0_, (unsigned)(b0_ >> 32), (unsigned)b1_, (unsigned)(b1_ >> 32)}; } while (0)
                TK_FINISH(itA, curA, a0, a1, TA);
                if (hasB) TK_FINISH(itB, curB, c0, c1, TB);
#undef TK_FINISH
            }
#undef TK_LOAD
        }
#endif
        gsync(lds);
#ifndef X_NOA3
        { PHASE_PTRS;
            unsigned* ctr = WSP(unsigned, WS_CTL) + 64 * (2 + 2 * L);
            const int r32 = lane & 31, hi = lane >> 5;
            for (;;) {
                __syncthreads();
                if (tid == 0) *s_item = (int)atomicAdd(ctr, 1u);
                __syncthreads();
                const int it = *s_item;
                if (it >= 1024) break;
                if (it >= 768) {
                    const int k = it - 768, qb = 31 - k / 8, bh = k % 8, b = bh >> 2, h = bh & 3, q0 = qb * 256;
                    const size_t rb = (size_t)b * SEQ;
                    f32x16 tot[2]; tot[0] = (f32x16){}; tot[1] = (f32x16){};
                    sb_unit(lds, wv0, PROJ + (rb + q0) * NPROJ + PC_SBQ + 64 * h, PROJ + rb * NPROJ + PC_SBK + 64 * h, PROJ + rb * NPROJ + PC_SBV + 64 * h, q0, tot);
                    store_o(tot, HN + (rb + q0 + 32 * wid + r32) * DM + 768 + h * 64, hi);
                    continue;
                }
                const int qb = 31 - it / 24, r24 = it % 24, bh = r24 % 12, b = bh / 6, h = bh % 6, g = h / 3, q0 = qb * 256;
                const size_t rb = (size_t)b * SEQ; const size_t qrow = rb + q0 + 32 * wid + r32;
                if (r24 < 12) {
                    f32x16 tot[2]; tot[0] = (f32x16){}; tot[1] = (f32x16){};
                    flash_unit<96, MODE_CAUSAL>(lds, wv0, QMLA + (rb + q0) * 576 + h * 96, 576, KVB + rb * 768 + h * 64, 768, PROJ + rb * NPROJ + PC_KR, NPROJ,
                                                KVB + rb * 768 + 384 + h * 64, 768, q0, 0, (q0 + 256) / 64, 0.10206207261596577f * LOG2E, (u32x4){}, 1.f, tot, nullptr, WSP(float, WS_ROPE));
                    store_o(tot, HN + qrow * DM + h * 64, hi);
                } else {
                    const float g1 = GATES[qrow * 32 + h * 3 + 1], g2 = GATES[qrow * 32 + h * 3 + 2];
                    const u32x4 mw = *(const u32x4*)(MASKS + ((size_t)(b * 2 + g) * SEQ + q0 + 32 * wid + r32) * 4);
                    f32x16 tot[2];
                    { const bf16_t* oc = OCMP + qrow * 384 + h * 64;
#pragma unroll
                      for (int d0 = 0; d0 < 2; ++d0)
#pragma unroll
                          for (int j = 0; j < 4; ++j) { const u32x2 w = *(const u32x2*)(oc + 32 * d0 + 8 * j + 4 * hi); tot[d0][4 * j] = bflo(w.x); tot[d0][4 * j + 1] = bfhi(w.x); tot[d0][4 * j + 2] = bflo(w.y); tot[d0][4 * j + 3] = bfhi(w.y); } }
                    const bf16_t* Qp = PROJ + (rb + q0) * NPROJ + PC_NQ + 64 * h;
                    flash_unit<64, MODE_SEL>(lds, wv0, Qp, NPROJ, PROJ + rb * NPROJ + PC_KS + 64 * g, NPROJ, nullptr, 0, PROJ + rb * NPROJ + PC_VS + 64 * g, NPROJ,
                                             q0, 0, (q0 + 256) / 64, 0.125f * LOG2E, mw, g1, tot, nullptr);
                    const int tw0 = (q0 >= 512) ? (q0 - 512) / 64 : 0;
                    flash_unit<64, MODE_WIN>(lds, wv0, Qp, NPROJ, PROJ + rb * NPROJ + PC_KW + 64 * g, NPROJ, nullptr, 0, PROJ + rb * NPROJ + PC_VW + 64 * g, NPROJ,
                                             q0, tw0, (q0 + 256) / 64, 0.125f * LOG2E, (u32x4){}, g2, tot, nullptr);
                    store_o(tot, HN + qrow * DM + 384 + h * 64, hi);
                }
            }
        }
#endif
        gsync(lds);
        { PHASE_PTRS; pg8::Gemm g{HN, Wout, MTOK, DM, DM, DM, DM}; pg8::StaticOrder S; S.init(MTOK, DM, G, bid); pg8::EpiResid E{X, X, DM, 1.0f}; pg8::gemm_phase(lds, g, S, E, wv0); }
        gsync(lds);
        { PHASE_PTRS; norm_rows(X, PIN(19) + L * DM, HN, gw, NGW, lane); }
        gsync(lds);
        { PHASE_PTRS; ffn_gemms(lds, grid, ws, X, X, G, bid, wv0); }
    }
    float* X = GET_X(); const float* fng = PIN(23); const int G = fresh_s(G0), bid = fresh_s(bid0), NGW = G * 8;
    const int tid = fresh_tid2(wv0), lane = tid & 63, wid = wv0, gw = bid * 8 + wid;
    for (int mrow = gw; mrow < MTOK; mrow += NGW) {
        f32x4* xr = (f32x4*)(X + (size_t)mrow * DM) + lane;
        f32x4 v[4]; float ss = 0.f;
#pragma unroll
        for (int j = 0; j < 4; ++j) { v[j] = xr[64 * j]; ss += (v[j].x * v[j].x + v[j].y * v[j].y) + (v[j].z * v[j].z + v[j].w * v[j].w); }
        const float r = rsqrtf(wave_sum(ss) * (1.f / DM) + EPS);
#pragma unroll
        for (int j = 0; j < 4; ++j) { const f32x4 gg = ((const f32x4*)fng)[lane + 64 * j]; xr[64 * j] = v[j] * r * gg; }
    }
}

#undef lds
extern "C" void kernel_launch(void* const* d_in, const int* in_sizes, int n_in, void* d_out, int out_size, void* d_ws, size_t ws_size, hipStream_t stream) {
    static int grid = 0;
    if (grid == 0) {
        if (n_in != 24 || out_size != MTOK * DM || ws_size < WS_END) { fprintf(stderr, "kernel_launch: unexpected shapes (n_in %d out %d ws %zu)\n", n_in, out_size, ws_size); grid = -1; return; }
        int dev = 0, cus = 0, per_cu = 0;
        hipGetDevice(&dev);
        hipDeviceGetAttribute(&cus, hipDeviceAttributeMultiprocessorCount, dev);
        hipFuncSetAttribute((const void*)mega_fwd, hipFuncAttributeMaxDynamicSharedMemorySize, LDS_BYTES);
        hipOccupancyMaxActiveBlocksPerMultiprocessor(&per_cu, (const void*)mega_fwd, 512, LDS_BYTES);
        if (per_cu < 1) per_cu = 1;
        grid = cus * 1;
        (void)hipGetLastError();
    }
    if (grid < 0) return;
    hipMemsetAsync((char*)d_ws + WS_CTL, 0, 65536, stream);
    Params p{};
    for (int i = 0; i < 24; ++i) p.in[i] = (const float*)d_in[i];
    p.out = (float*)d_out; p.ws = (unsigned char*)d_ws;
    void* args[] = {&p};
    hipError_t e = hipLaunchCooperativeKernel((const void*)mega_fwd, dim3(grid), dim3(512), args, LDS_BYTES, stream);
    if (e != hipSuccess) fprintf(stderr, "cooperative launch failed: %s (grid %d)\n", hipGetErrorString(e), grid);
}
```
